# Optimizing an MI355X kernel written in HIP

```python
import jax, jax.numpy as jnp
from jax import lax
import numpy as np

D_MODEL = 1024
BATCH = 8
SEQ = 2048
DEPTH = 2

HEAD_DIM = 64
N_BRANCHES = 4
BRANCH_WIDTH = D_MODEL // N_BRANCHES
BRANCH_HEADS = BRANCH_WIDTH // HEAD_DIM
MOBA_BLOCK = 256
MOBA_TOPK = 3
MOBA_QCHUNK = 32
GLA_KEY_DIM = HEAD_DIM // 2
GLA_GATE_RANK = 16
GLA_GATE_TEMP = 16.0
LINEAR_CHUNK = 64
RET_DECAY_BASE = 5.0
SWA_KV_HEADS = 2
WINDOW = 128
N_ALIBI_HEADS = 2 * BRANCH_HEADS
N_EXPERTS = 32
TOP_K = 4
D_EXPERT = D_MODEL
SWIGLU_ALPHA = 1.702
SWIGLU_LIMIT = 7.0
NORM_EPS = 1e-5

GLA_QK_WIDTH = BRANCH_HEADS * GLA_KEY_DIM
SWA_KV_WIDTH = SWA_KV_HEADS * HEAD_DIM
IN_SIZES = (
    BRANCH_WIDTH, BRANCH_WIDTH, BRANCH_WIDTH,
    GLA_QK_WIDTH, GLA_QK_WIDTH, BRANCH_WIDTH, GLA_GATE_RANK, BRANCH_WIDTH,
    BRANCH_WIDTH, BRANCH_WIDTH, BRANCH_WIDTH, BRANCH_WIDTH,
    BRANCH_WIDTH, SWA_KV_WIDTH, SWA_KV_WIDTH,
    N_BRANCHES * D_MODEL,
)
D_IN = sum(IN_SIZES)

kernel_name = "hybrid_moba_gla_retnet_swa_moe_block"


def rms_norm(x, g):
    xf = x.astype(jnp.float32)
    y = xf * lax.rsqrt(jnp.mean(xf * xf, axis=-1, keepdims=True) + NORM_EPS)
    return (y * g.astype(jnp.float32)).astype(x.dtype)


def split_cols(z, sizes):
    offs = [int(o) for o in np.cumsum(sizes)[:-1]]
    return jnp.split(z, offs, axis=-1)


def to_heads(t, n_heads):
    b, s, _ = t.shape
    return t.reshape(b, s, n_heads, -1).transpose(0, 2, 1, 3)


def from_heads(o):
    b, h, s, d = o.shape
    return o.transpose(0, 2, 1, 3).reshape(b, s, h * d)


def head_rms_norm(o, g):
    h, d = o.shape[1], o.shape[3]
    of = o.astype(jnp.float32)
    y = of * lax.rsqrt(jnp.mean(of * of, axis=-1, keepdims=True) + NORM_EPS)
    return y * g.astype(jnp.float32).reshape(1, h, 1, d)


def head_group_norm(o, g):
    h, d = o.shape[1], o.shape[3]
    of = o.astype(jnp.float32)
    mu = jnp.mean(of, axis=-1, keepdims=True)
    var = jnp.mean(jnp.square(of - mu), axis=-1, keepdims=True)
    return (of - mu) * lax.rsqrt(var + NORM_EPS) * g.astype(jnp.float32).reshape(1, h, 1, d)


def moba_attention(q, k, v, slopes):
    B, H, S, dh = q.shape
    n_blocks = -(-S // MOBA_BLOCK)
    s_pad = n_blocks * MOBA_BLOCK
    pad = ((0, 0), (0, 0), (0, s_pad - S), (0, 0))
    q, k, v = jnp.pad(q, pad), jnp.pad(k, pad), jnp.pad(v, pad)
    kb = k.reshape(B, H, n_blocks, MOBA_BLOCK, dh)
    vb = v.reshape(B, H, n_blocks, MOBA_BLOCK, dh)
    k_mean = jnp.mean(kb.astype(jnp.float32), axis=3)
    k_sel = min(MOBA_TOPK, n_blocks)
    scale = dh ** -0.5
    b_idx = jnp.arange(B)[:, None, None, None]
    h_idx = jnp.arange(H)[None, :, None, None]
    sl = slopes.astype(jnp.float32)
    blk_offs = jnp.arange(MOBA_BLOCK)

    def chunk_fn(ci):
        start = ci * MOBA_QCHUNK
        q_c = lax.dynamic_slice_in_dim(q, start, MOBA_QCHUNK, axis=2)
        t = (start + jnp.arange(MOBA_QCHUNK)).astype(jnp.float32)
        blk = start // MOBA_BLOCK
        gate = jnp.einsum('bhqd,bhnd->bhqn', q_c.astype(jnp.float32), k_mean)
        gate = jnp.where(jnp.arange(n_blocks) < blk, gate, -jnp.inf)
        _, idx = lax.top_k(gate, k_sel)
        valid = idx < blk
        k_g = kb[b_idx, h_idx, idx]
        v_g = vb[b_idx, h_idx, idx]
        s_g = jnp.einsum('bhqd,bhqjsd->bhqjs', q_c, k_g).astype(jnp.float32) * scale
        pos_g = (idx[..., None] * MOBA_BLOCK + blk_offs).astype(jnp.float32)
        dist_g = t[None, None, :, None, None] - pos_g
        s_g = jnp.where(valid[..., None], s_g - sl[None, :, None, None, None] * dist_g, -jnp.inf)
        k_o = lax.dynamic_index_in_dim(kb, blk, axis=2, keepdims=False)
        v_o = lax.dynamic_index_in_dim(vb, blk, axis=2, keepdims=False)
        s_o = jnp.einsum('bhqd,bhsd->bhqs', q_c, k_o).astype(jnp.float32) * scale
        dist_o = t[:, None] - (blk * MOBA_BLOCK + blk_offs).astype(jnp.float32)[None, :]
        s_o = jnp.where(dist_o >= 0, s_o - sl[None, :, None, None] * dist_o, -jnp.inf)
        logits = jnp.concatenate([s_g.reshape(B, H, MOBA_QCHUNK, k_sel * MOBA_BLOCK), s_o], axis=-1)
        p = jax.nn.softmax(logits, axis=-1)
        p_g = p[..., :k_sel * MOBA_BLOCK].reshape(B, H, MOBA_QCHUNK, k_sel, MOBA_BLOCK).astype(v.dtype)
        p_o = p[..., k_sel * MOBA_BLOCK:].astype(v.dtype)
        return (jnp.einsum('bhqjs,bhqjsd->bhqd', p_g, v_g)
                + jnp.einsum('bhqs,bhsd->bhqd', p_o, v_o))

    out = lax.map(chunk_fn, jnp.arange(s_pad // MOBA_QCHUNK))
    out = out.transpose(1, 2, 0, 3, 4).reshape(B, H, s_pad, dh)
    return out[:, :, :S]


def chunked_decay_linear_attention(q, k, v, log_a):
    B, H, S, dk = q.shape
    dv = v.shape[-1]
    L = LINEAR_CHUNK
    N = S // L
    q, k, v, log_a = (t.astype(jnp.float32).reshape(B, H, N, L, t.shape[-1]) for t in (q, k, v, log_a))
    b = jnp.cumsum(log_a, axis=3)
    b_end = b[:, :, :, -1:, :]
    q_dec = q * jnp.exp(b)
    k_in = k * jnp.exp(-b)
    k_end = k * jnp.exp(b_end - b)
    causal = jnp.tril(jnp.ones((L, L), dtype=bool))
    a = jnp.where(causal, jnp.einsum('bhnld,bhnmd->bhnlm', q_dec, k_in), 0.0)
    o_intra = jnp.einsum('bhnlm,bhnmv->bhnlv', a, v)
    kv = jnp.einsum('bhnld,bhnlv->nbhdv', k_end, v)
    decay = jnp.exp(jnp.moveaxis(b_end[:, :, :, 0, :], 2, 0))

    def step(state, inp):
        kv_n, d_n = inp
        return d_n[..., None] * state + kv_n, state

    _, s_prev = lax.scan(step, jnp.zeros((B, H, dk, dv), jnp.float32), (kv, decay))
    o_inter = jnp.einsum('bhnld,nbhdv->bhnlv', q_dec, s_prev)
    return (o_intra + o_inter).reshape(B, H, S, dv)


def sliding_window_attention(q, k, v, sinks, slopes):
    B, Hq, S, dh = q.shape
    Hkv = k.shape[1]
    G = Hq // Hkv
    W = WINDOW
    nq = S // W
    qb = q.reshape(B, Hkv, G, nq, W, dh)

    def band(t):
        tp = jnp.pad(t, ((0, 0), (0, 0), (W, 0), (0, 0))).reshape(B, Hkv, nq + 1, W, dh)
        return jnp.concatenate([tp[:, :, :-1], tp[:, :, 1:]], axis=3)

    kb, vb = band(k), band(v)
    s = jnp.einsum('bkgnqd,bknsd->bkgnqs', qb, kb).astype(jnp.float32) * dh ** -0.5
    dist = (W + jnp.arange(W)[:, None] - jnp.arange(2 * W)[None, :])
    key_pos = jnp.arange(nq)[:, None] * W - W + jnp.arange(2 * W)[None, :]
    allowed = (dist >= 0)[None] & (dist < W)[None] & (key_pos >= 0)[:, None, :]
    sl = slopes.astype(jnp.float32).reshape(Hkv, G)[None, :, :, None, None, None]
    s = jnp.where(allowed, s - sl * dist.astype(jnp.float32), -jnp.inf)
    sink = jnp.broadcast_to(sinks.astype(jnp.float32).reshape(Hkv, G)[None, :, :, None, None, None],
                            s.shape[:-1] + (1,))
    p = jax.nn.softmax(jnp.concatenate([s, sink], axis=-1), axis=-1)[..., :-1]
    o = jnp.einsum('bkgnqs,bknsd->bkgnqd', p.astype(v.dtype), vb)
    return o.reshape(B, Hq, S, dh)


def moe_ffn(h, w_router, b_router, w_gate_up, b_gate_up, w_down, b_down):
    logits = (h @ w_router + b_router).astype(jnp.float32)
    top_vals, top_idx = lax.top_k(logits, TOP_K)
    weights = jax.nn.softmax(top_vals, axis=-1)
    combine = jnp.einsum('tk,tke->te', weights,
                         jax.nn.one_hot(top_idx, N_EXPERTS, dtype=jnp.float32)).astype(h.dtype)
    y = jnp.zeros_like(h)
    for e in range(N_EXPERTS):
        gu = h @ w_gate_up[e] + b_gate_up[e]
        x_glu, x_lin = jnp.split(gu, 2, axis=-1)
        x_glu = jnp.minimum(x_glu, SWIGLU_LIMIT)
        x_lin = jnp.clip(x_lin, -SWIGLU_LIMIT, SWIGLU_LIMIT)
        act = x_glu * jax.nn.sigmoid(SWIGLU_ALPHA * x_glu) * (x_lin + 1.0)
        y = y + combine[:, e:e + 1] * (act @ w_down[e] + b_down[e])
    return y


def setup_inputs(seed: int = 0) -> dict:
    key = jax.random.key(seed)
    ks = jax.random.split(key, 22)
    f32 = jnp.float32
    nrm = lambda k, shape, s: jax.random.normal(k, shape, f32) * s
    return {
        "x": nrm(ks[0], (BATCH, SEQ, D_MODEL), 1.0),
        "c": nrm(ks[1], (BATCH, D_MODEL), 1.0),
        "w_ada": nrm(ks[2], (DEPTH, D_MODEL, 6 * D_MODEL), 0.5 * D_MODEL ** -0.5),
        "b_ada": nrm(ks[3], (DEPTH, 6 * D_MODEL), 0.01),
        "g_norm_mix": 1.0 + nrm(ks[4], (DEPTH, D_MODEL), 0.01),
        "w_in": nrm(ks[5], (DEPTH, D_MODEL, D_IN), D_MODEL ** -0.5),
        "w_gla_gate": nrm(ks[6], (DEPTH, GLA_GATE_RANK, GLA_QK_WIDTH), GLA_GATE_RANK ** -0.5),
        "b_gla_gate": nrm(ks[7], (DEPTH, GLA_QK_WIDTH), 0.1),
        "g_gla_norm": 1.0 + nrm(ks[8], (DEPTH, BRANCH_WIDTH), 0.01),
        "g_ret_norm": 1.0 + nrm(ks[9], (DEPTH, BRANCH_WIDTH), 0.01),
        "attn_sinks": nrm(ks[10], (DEPTH, BRANCH_HEADS), 1.0),
        "w_branch": nrm(ks[11], (DEPTH, N_BRANCHES, BRANCH_WIDTH, D_MODEL), BRANCH_WIDTH ** -0.5),
        "w_out": nrm(ks[12], (DEPTH, D_MODEL, D_MODEL), D_MODEL ** -0.5),
        "g_norm_ffn": 1.0 + nrm(ks[13], (DEPTH, D_MODEL), 0.01),
        "w_router": nrm(ks[14], (DEPTH, D_MODEL, N_EXPERTS), D_MODEL ** -0.5),
        "b_router": nrm(ks[15], (DEPTH, N_EXPERTS), 0.01),
        "w_gate_up": nrm(ks[16], (DEPTH, N_EXPERTS, D_MODEL, 2 * D_EXPERT), D_MODEL ** -0.5),
        "b_gate_up": nrm(ks[17], (DEPTH, N_EXPERTS, 2 * D_EXPERT), 0.01),
        "w_down": nrm(ks[18], (DEPTH, N_EXPERTS, D_EXPERT, D_MODEL), D_EXPERT ** -0.5),
        "b_down": nrm(ks[19], (DEPTH, N_EXPERTS, D_MODEL), 0.01),
        "g_final": 1.0 + nrm(ks[20], (D_MODEL,), 0.01),
    }


def reference(x, c, w_ada, b_ada, g_norm_mix, w_in, w_gla_gate, b_gla_gate, g_gla_norm, g_ret_norm,
              attn_sinks, w_branch, w_out, g_norm_ffn, w_router, b_router, w_gate_up, b_gate_up,
              w_down, b_down, g_final):
    B, S, D = x.shape
    H = BRANCH_HEADS
    slopes = 2.0 ** (-(jnp.arange(N_ALIBI_HEADS, dtype=jnp.float32) + 1.0) * (8.0 / N_ALIBI_HEADS))
    swa_slopes, moba_slopes = slopes[:H], slopes[H:]
    log_gamma = jnp.log(1.0 - 2.0 ** (-RET_DECAY_BASE - jnp.arange(H, dtype=jnp.float32)))
    c_act = jax.nn.silu(c)

    for l in range(DEPTH):
        mod = c_act @ w_ada[l] + b_ada[l]
        shift1, scale1, gate1, shift2, scale2, gate2 = (m[:, None, :] for m in jnp.split(mod, 6, axis=-1))

        h = rms_norm(x, g_norm_mix[l]) * (1.0 + scale1) + shift1
        z = h @ w_in[l]
        (mq, mk, mv, gq, gk, gv, ga, gr, rq, rk, rv, rg, sq, sk, sv, merge_logits) = split_cols(z, IN_SIZES)

        y_moba = from_heads(moba_attention(to_heads(mq, H), to_heads(mk, H), to_heads(mv, H), moba_slopes))

        gate_logit = ga @ w_gla_gate[l] + b_gla_gate[l]
        log_a = jax.nn.log_sigmoid(gate_logit.astype(jnp.float32)) / GLA_GATE_TEMP
        o_gla = chunked_decay_linear_attention(to_heads(gq, H) * GLA_KEY_DIM ** -0.5, to_heads(gk, H),
                                               to_heads(gv, H), to_heads(log_a, H))
        y_gla = (from_heads(head_rms_norm(o_gla, g_gla_norm[l])) * jax.nn.silu(gr.astype(jnp.float32))).astype(x.dtype)

        ret_log_a = jnp.broadcast_to(log_gamma[None, :, None, None], (B, H, S, HEAD_DIM))
        o_ret = chunked_decay_linear_attention(to_heads(rq, H), to_heads(rk, H) * HEAD_DIM ** -0.5,
                                               to_heads(rv, H), ret_log_a)
        y_ret = (from_heads(head_group_norm(o_ret, g_ret_norm[l])) * jax.nn.silu(rg.astype(jnp.float32))).astype(x.dtype)

        y_swa = from_heads(sliding_window_attention(to_heads(sq, H), to_heads(sk, SWA_KV_HEADS),
                                                    to_heads(sv, SWA_KV_HEADS), attn_sinks[l], swa_slopes))

        ys = jnp.stack([y_moba, y_gla, y_ret, y_swa], axis=2)
        up = jnp.einsum('bsnc,ncd->bsnd', ys, w_branch[l])
        gates = jax.nn.sigmoid(merge_logits.reshape(B, S, N_BRANCHES, D))
        mixed = jnp.sum(gates * up, axis=2) @ w_out[l]
        x = x + gate1 * mixed

        h2 = rms_norm(x, g_norm_ffn[l]) * (1.0 + scale2) + shift2
        y_ffn = moe_ffn(h2.reshape(B * S, D), w_router[l], b_router[l], w_gate_up[l], b_gate_up[l],
                        w_down[l], b_down[l]).reshape(B, S, D)
        x = x + gate2 * y_ffn

    return rms_norm(x, g_final)
```

```cpp
#include <hip/hip_runtime.h>
#include <cstdint>
#include <cstdio>

#ifndef MK_PER_PHASE
#define MK_PER_PHASE 1
#endif

#define GAS __attribute__((address_space(1)))
#define LAS __attribute__((address_space(3)))
typedef unsigned short bf16;
typedef short bf16x8 __attribute__((ext_vector_type(8)));
typedef float f32x4 __attribute__((ext_vector_type(4)));
typedef float f32x16 __attribute__((ext_vector_type(16)));
typedef unsigned u32x4 __attribute__((ext_vector_type(4)));
typedef unsigned u32x2 __attribute__((ext_vector_type(2)));
typedef float f32x2_t __attribute__((ext_vector_type(2)));
typedef __bf16 bf16x2_t __attribute__((ext_vector_type(2)));

constexpr int NB = 8, SEQ = 2048, DM = 1024, T = NB * SEQ, DEPTH = 2, NH = 4;
constexpr int DIN = 7184;
constexpr int ZW = 7424;
constexpr int C_MQ = 0, C_MK = 256, C_MV = 512, C_GQ = 768, C_GK = 896, C_GV = 1024, C_GLOG = 1280, C_GR = 1408, C_RQ = 1664, C_RK = 1920, C_RV = 2176,
              C_RG = 2432, C_SQ = 2688, C_SK = 2944, C_SV = 3072, C_PAD = 3200, C_MERGE = 3328;
constexpr int ZT_VM = 0, ZT_KG = 256, ZT_VG = 384, ZT_KR = 640, ZT_VR = 896, ZT_VS = 1152, ZT_ROWS = 1280;
constexpr int NE = 32, TOPK = 4;
constexpr int ACT_ROWS = T * TOPK + NE * 256;
constexpr float NORM_EPS = 1e-5f;
constexpr float LOG2E = 1.4426950408889634f;

constexpr size_t MiB = (size_t)1 << 20;
constexpr size_t WS_CTL = 0, CTL_ZERO_BYTES = 1 * MiB;
constexpr size_t WS_MOD = 1 * MiB;
constexpr size_t WS_KMEAN = 2 * MiB;
constexpr size_t WS_SELE = 3 * MiB, WS_SELP = 3 * MiB + 512 * 1024;
constexpr size_t WS_LTOK = 4 * MiB, WS_LW = 6 * MiB;
constexpr size_t WS_KVG = 8 * MiB;
constexpr size_t WS_DECG = 16 * MiB;
constexpr size_t WS_KVR = 18 * MiB;
constexpr size_t WS_BCUM = 34 * MiB;
constexpr size_t WS_WIN = 48 * MiB, WIN_STRIDE = 15 * MiB;
constexpr size_t WS_WBR = 78 * MiB;
constexpr size_t WS_WOUT = 82 * MiB;
constexpr size_t WS_WGU = 96 * MiB;
constexpr size_t WS_WDN = 352 * MiB;
constexpr size_t WS_H = 480 * MiB;
constexpr size_t WS_Z = 512 * MiB;
constexpr size_t WS_ZT = 744 * MiB;
constexpr size_t WS_YS = 784 * MiB;
constexpr size_t WS_PART = 816 * MiB;
constexpr size_t WS_MIX = 880 * MiB;
constexpr size_t WS_ACT = 512 * MiB;
constexpr size_t WS_YB = 656 * MiB;
constexpr size_t WS_X1 = 912 * MiB, WS_X2 = 976 * MiB;
constexpr size_t WS_END = 1040 * MiB;
static_assert(WS_YB + (size_t)ACT_ROWS * 1024 * 2 <= WS_X1, "overlay fits");
static_assert((size_t)ZW * 1024 * 2 <= WIN_STRIDE, "w_in copy fits");
constexpr int CW_TMO = 0, CW_BAR = 4096, CW_CNT = 8192, CW_Q = 12288;

constexpr int RING_BYTES = 131072;
constexpr int LDSCTL_OFF = RING_BYTES;
constexpr int L_CNT = LDSCTL_OFF + 0, L_TST = LDSCTL_OFF + 256, L_HIST = LDSCTL_OFF + 512, L_GBASE = LDSCTL_OFF + 768, L_MISC = LDSCTL_OFF + 1024;
constexpr int LDS_BYTES = 147456;
constexpr int NWAVES = 8;

__device__ __forceinline__ float bf2f(unsigned short u) { return __uint_as_float((unsigned)u << 16); }
__device__ __forceinline__ unsigned cvtpk(float lo, float hi) { f32x2_t v = {lo, hi}; bf16x2_t b = __builtin_convertvector(v, bf16x2_t); return __builtin_bit_cast(unsigned, b); }
__device__ __forceinline__ bf16 f2bf(float f) { return (bf16)(cvtpk(f, 0.f) & 0xffffu); }
__device__ __forceinline__ bf16x8 pack8(const float* v) { u32x4 p; p.x = cvtpk(v[0], v[1]); p.y = cvtpk(v[2], v[3]); p.z = cvtpk(v[4], v[5]); p.w = cvtpk(v[6], v[7]); return __builtin_bit_cast(bf16x8, p); }
__device__ __forceinline__ bf16x8 ld8(const bf16* p) { return *(const bf16x8*)p; }
__device__ __forceinline__ float wave_sum(float v) {
#pragma unroll
    for (int o = 1; o < 64; o <<= 1) v += __shfl_xor(v, o);
    return v;
}
__device__ __forceinline__ float fexp2(float x) { return __builtin_amdgcn_exp2f(x); }
__device__ __forceinline__ float sigmoidf_(float x) { return 1.0f / (1.0f + __expf(-x)); }
__device__ __forceinline__ float siluf_(float x) { return x / (1.0f + __expf(-x)); }
#define MFMA32(a, b, c) __builtin_amdgcn_mfma_f32_32x32x16_bf16((a), (b), (c), 0, 0, 0)
__device__ __forceinline__ int swap23(int r) { return (r & ~12) | ((r & 8) >> 1) | ((r & 4) << 1); }
__device__ __forceinline__ int crow(int reg, int h) { return (reg & 3) + 8 * (reg >> 2) + 4 * h; }

namespace pg8 {
typedef unsigned short bf16_t;
constexpr int BM = 256, BK = 64, HALF = 128, HTB = HALF * BK * 2, NXCD = 8, WGM = 8;
__device__ __forceinline__ int lds_byte(int r, int c) { const int st = (r >> 4) * 2 + (c >> 5), rr = r & 15, cc = c & 31, ob = rr * 64 + cc * 2; return st * 1024 + (ob ^ (((ob >> 9) & 1) << 5)); }
__device__ __forceinline__ void stage_rc(int b, int& R, int& C) { const int st = b / 1024, sb = b % 1024, swz = sb ^ (((sb >> 9) & 1) << 5); R = (st >> 1) * 16 + swz / 64; C = (st & 1) * 32 + (swz % 64) / 2; }
__device__ __forceinline__ int perm32(int rho) { const int n = rho >> 4, i = rho & 15; return 8 * (i >> 2) + 4 * n + (i & 3); }

struct Unit { int pm, pn, e, rows, l0; };
struct GemmDesc { const bf16_t* A; int lda, ldb, K; };

struct TileOrder {
    int nM, nN, nwg, G, c;
    __device__ __forceinline__ void init(int nM_, int nN_, int G_, int c_) { nM = nM_; nN = nN_; nwg = nM * nN; G = G_; c = c_; }
    __device__ __forceinline__ bool map(int i, int& pm, int& pn) const {
        const long L = (long)i * G + c; if (L >= nwg) return false;
        int wgid = (int)L; { const int q = nwg / NXCD, r = nwg % NXCD, xcd = wgid % NXCD, off = wgid / NXCD; wgid = (xcd < r ? xcd * (q + 1) : r * (q + 1) + (xcd - r) * q) + off; }
        const int nig = WGM * nN, gid = wgid / nig, fm = gid * WGM, gsz = (nM - fm) < WGM ? (nM - fm) : WGM;
        pm = fm + ((wgid % nig) % gsz); pn = (wgid % nig) / gsz; return true;
    }
};
struct SchedPlain {
    static constexpr bool GATHER = false;
    TileOrder o; const bf16_t* Bt;
    __device__ __forceinline__ bool next(int i, Unit& u) const { u.e = 0; u.rows = 256; u.l0 = 0; return o.map(i, u.pm, u.pn); }
    __device__ __forceinline__ int a_row(const Unit&, int) const { return 0; }
    __device__ __forceinline__ const char* a_base(const GemmDesc& g, const Unit& u) const { return (const char*)(g.A + (size_t)u.pm * 256 * g.lda); }
    __device__ __forceinline__ const char* b_tile(const GemmDesc& g, const Unit& u) const { return (const char*)(Bt + (size_t)u.pn * 256 * g.ldb); }
};
struct SchedSeg {
    static constexpr bool GATHER = false;
    TileOrder o; const bf16_t* Bt;
    __device__ __forceinline__ bool next(int i, Unit& u) const { u.e = i & 3; u.rows = 256; u.l0 = 0; return o.map(i >> 2, u.pm, u.pn); }
    __device__ __forceinline__ int a_row(const Unit&, int) const { return 0; }
    __device__ __forceinline__ const char* a_base(const GemmDesc& g, const Unit& u) const { return (const char*)(g.A + (size_t)u.pm * 256 * g.lda + u.e * 256); }
    __device__ __forceinline__ const char* b_tile(const GemmDesc& g, const Unit& u) const { return (const char*)(Bt + (size_t)u.e * 1024 * 256 + (size_t)u.pn * 256 * g.ldb); }
};
template <bool GATHER_> struct SchedMoe {
    static constexpr bool GATHER = GATHER_;
    TileOrder o; const bf16_t* Bt; size_t estride; const LAS int* tstart; const LAS int* cnt; const int* ltok;
    __device__ __forceinline__ bool next(int i, Unit& u) const {
        int mt; if (!o.map(i, mt, u.pn)) return false;
        int e = 0; while (e < NE - 1 && tstart[e + 1] <= mt) ++e;
        u.pm = mt; u.e = e; u.l0 = (mt - tstart[e]) * 256; const int left = cnt[e] - u.l0; u.rows = left < 256 ? left : 256; return true;
    }
    __device__ __forceinline__ int a_row(const Unit& u, int r) const { return (r < u.rows) ? ltok[(size_t)u.e * T + u.l0 + r] : 0; }
    __device__ __forceinline__ const char* a_base(const GemmDesc& g, const Unit& u) const { return GATHER ? (const char*)g.A : (const char*)(g.A + (size_t)u.pm * 256 * g.lda); }
    __device__ __forceinline__ const char* b_tile(const GemmDesc& g, const Unit& u) const { return (const char*)(Bt + (size_t)u.e * estride + (size_t)u.pn * 256 * g.ldb); }
};

template <class Epi, class Sched>
__device__ __forceinline__ void gemm_phase(LAS unsigned char* lds, const GemmDesc g, const Sched& S, const Epi& E) {
    const int tid = threadIdx.x, wid = __builtin_amdgcn_readfirstlane(tid >> 6), lane = tid & 63, wr = wid >> 2, wc = wid & 3, fr = lane & 15, fq = lane >> 4;
    const int K = g.K, nt = K / BK;
    constexpr bool GATHER = Sched::GATHER;
    int Rr[2], Cc[2]; unsigned voffB[2], offA[2][2];
#pragma unroll
    for (int i = 0; i < 2; ++i) { int R, C; stage_rc(tid * 16 + i * 8192, R, C); Rr[i] = R; Cc[i] = C; const int Rb = Epi::PERM ? ((R & ~31) + perm32(R & 31)) : R; voffB[i] = (unsigned)(Rb * g.ldb + C) * 2u;
        offA[0][i] = (unsigned)(R * g.lda + C) * 2u; offA[1][i] = offA[0][i]; }
    const size_t kstep = (size_t)(BK * 2);
    const size_t hstepB = (size_t)HALF * g.ldb * 2;
    const size_t hstepA = GATHER ? (size_t)0 : (size_t)HALF * g.lda * 2;
    const unsigned ldsw = (unsigned)wid * 1024u;
    const int aoff = lds_byte(wr * 64 + fr, fq * 8), boff = lds_byte(wc * 32 + fr, fq * 8);
#define PG8_SA(b, h) (((b) * 2 + (h)) * HTB)
#define PG8_SB(b, h) ((4 + (b) * 2 + (h)) * HTB)
#define PG8_STAGE(bufoff, gbase, voff) do { _Pragma("unroll") for (int _i = 0; _i < 2; ++_i) \
        __builtin_amdgcn_global_load_lds((const unsigned*)((const char*)(gbase) + (voff)[_i]), (LAS unsigned*)(lds + (bufoff) + ldsw + _i * 8192), 16, 0, 0); } while (0)
#define PG8_LDA(dst, b, h) do { _Pragma("unroll") for (int m = 0; m < 4; ++m) _Pragma("unroll") for (int k = 0; k < 2; ++k) dst[m][k] = *(const LAS bf16x8*)(lds + PG8_SA(b, h) + aoff + m * 2048 + k * 1024); } while (0)
#define PG8_LDB(dst, b, h) do { _Pragma("unroll") for (int n = 0; n < 2; ++n) _Pragma("unroll") for (int k = 0; k < 2; ++k) dst[n][k] = *(const LAS bf16x8*)(lds + PG8_SB(b, h) + boff + n * 2048 + k * 1024); } while (0)
#define PG8_MMA(ai, bj, At, Bt) do { __builtin_amdgcn_s_setprio(1); _Pragma("unroll") for (int m = 0; m < 4; ++m) _Pragma("unroll") for (int n = 0; n < 2; ++n) _Pragma("unroll") for (int k = 0; k < 2; ++k) \
        acc[ai][bj][m][n] = __builtin_amdgcn_mfma_f32_16x16x32_bf16(Bt[n][k], At[m][k], acc[ai][bj][m][n], 0, 0, 0); __builtin_amdgcn_s_setprio(0); } while (0)
#define PG8_WAIT_V(n) asm volatile("s_waitcnt vmcnt(" #n ")" ::: "memory")
#define PG8_WAIT_L(n) asm volatile("s_waitcnt lgkmcnt(" #n ")" ::: "memory")
#define PG8_BAR __builtin_amdgcn_s_barrier()
#define PG8_SCHED __builtin_amdgcn_sched_barrier(0)
#define PG8_AOFF(u) do { if (GATHER) { _Pragma("unroll") for (int _h = 0; _h < 2; ++_h) _Pragma("unroll") for (int _i = 0; _i < 2; ++_i) offA[_h][_i] = (unsigned)(S.a_row(u, _h * 128 + Rr[_i]) * g.lda + Cc[_i]) * 2u; } } while (0)
    Unit cur, nxt; int ui = 0;
    if (!S.next(0, cur)) return;
    f32x4 acc[2][2][4][2];
#pragma unroll
    for (int a = 0; a < 2; ++a)
#pragma unroll
        for (int b = 0; b < 2; ++b)
#pragma unroll
            for (int m = 0; m < 4; ++m)
#pragma unroll
                for (int n = 0; n < 2; ++n) acc[a][b][m][n] = (f32x4){0.f, 0.f, 0.f, 0.f};
    bf16x8 At[4][2], B0[2][2], B1[2][2];
    PG8_AOFF(cur);
    const char* cA = S.a_base(g, cur); const char* cB = S.b_tile(g, cur);
    PG8_STAGE(PG8_SB(0, 0), cB, voffB); PG8_STAGE(PG8_SB(0, 1), cB + hstepB, voffB); PG8_STAGE(PG8_SA(0, 0), cA, offA[0]); PG8_STAGE(PG8_SA(0, 1), cA + hstepA, offA[1]);
    if (wr == 1) PG8_BAR;
    PG8_WAIT_V(2); PG8_BAR;
    PG8_STAGE(PG8_SB(1, 0), cB + kstep, voffB); PG8_STAGE(PG8_SA(1, 0), cA + kstep, offA[0]); PG8_STAGE(PG8_SB(1, 1), cB + hstepB + kstep, voffB);
    PG8_WAIT_V(6); PG8_BAR;
    for (;;) {
        const bool has_next = S.next(ui + 1, nxt);
        const char* nA = cA; const char* nB = cB;
        if (has_next) { nA = S.a_base(g, nxt); nB = S.b_tile(g, nxt); }
#pragma nounroll
        for (int t = 0; t < nt; t += 2) {
            const bool last = (t == nt - 2);
            const char* a1 = cA + (size_t)(t + 1) * kstep;
            const char* a2 = last ? nA : cA + (size_t)(t + 2) * kstep; const char* b2 = last ? nB : cB + (size_t)(t + 2) * kstep;
            const char* a3 = a2 + kstep; const char* b3 = b2 + kstep;
            PG8_LDB(B0, 0, 0); PG8_LDB(B1, 0, 1); PG8_SCHED; PG8_LDA(At, 0, 0); PG8_STAGE(PG8_SA(1, 1), a1 + hstepA, offA[1]);
            if (GATHER) { if (last && has_next) PG8_AOFF(nxt); }
            PG8_WAIT_V(8); PG8_WAIT_L(0); PG8_BAR; PG8_MMA(0, 0, At, B0); PG8_MMA(0, 1, At, B1); PG8_BAR; PG8_SCHED;
            PG8_LDA(At, 0, 1); PG8_STAGE(PG8_SB(0, 0), b2, voffB); PG8_STAGE(PG8_SB(0, 1), b2 + hstepB, voffB); PG8_STAGE(PG8_SA(0, 0), a2, offA[0]);
            PG8_WAIT_V(8); PG8_WAIT_L(0); PG8_BAR; PG8_MMA(1, 0, At, B0); PG8_MMA(1, 1, At, B1); PG8_BAR; PG8_SCHED;
            PG8_LDB(B0, 1, 0); PG8_LDB(B1, 1, 1); PG8_SCHED; PG8_LDA(At, 1, 0); PG8_STAGE(PG8_SA(0, 1), a2 + hstepA, offA[1]);
            PG8_WAIT_V(8); PG8_WAIT_L(0); PG8_BAR; PG8_MMA(0, 0, At, B0); PG8_MMA(0, 1, At, B1); PG8_BAR; PG8_SCHED;
            PG8_LDA(At, 1, 1); PG8_STAGE(PG8_SB(1, 0), b3, voffB); PG8_STAGE(PG8_SB(1, 1), b3 + hstepB, voffB); PG8_STAGE(PG8_SA(1, 0), a3, offA[0]);
            PG8_WAIT_V(8); PG8_WAIT_L(0); PG8_BAR; PG8_MMA(1, 0, At, B0); PG8_MMA(1, 1, At, B1); PG8_BAR; PG8_SCHED;
        }
        if (wr == 0) PG8_BAR;
        E(acc, cur, wr, wc, fr, fq);
        if (!has_next) break;
#pragma unroll
        for (int a = 0; a < 2; ++a)
#pragma unroll
            for (int b = 0; b < 2; ++b)
#pragma unroll
                for (int m = 0; m < 4; ++m)
#pragma unroll
                    for (int n = 0; n < 2; ++n) acc[a][b][m][n] = (f32x4){0.f, 0.f, 0.f, 0.f};
        cur = nxt; cA = nA; cB = nB; ++ui;
        if (wr == 1) PG8_BAR;
    }
    PG8_WAIT_V(0);
    PG8_BAR;
#undef PG8_SA
#undef PG8_SB
#undef PG8_STAGE
#undef PG8_LDA
#undef PG8_LDB
#undef PG8_MMA
#undef PG8_WAIT_V
#undef PG8_WAIT_L
#undef PG8_BAR
#undef PG8_SCHED
#undef PG8_AOFF
}

struct EpiInProj {
    static constexpr bool PERM = true;
    bf16_t* Z; bf16_t* ZT;
    __device__ __forceinline__ void operator()(const f32x4 (&acc)[2][2][4][2], const Unit& u, int wr, int wc, int fr, int fq) const {
        const int row0 = u.pm * BM + wr * 64 + fr;
#pragma unroll
        for (int bj = 0; bj < 2; ++bj) {
            const int g = 2 * u.pn + bj;
            int tb = -1;
            switch (g) { case 4: tb = 0; break; case 5: tb = 128; break; case 7: tb = 256; break; case 8: tb = 384; break; case 9: tb = 512; break; case 15: tb = 640; break;
                         case 16: tb = 768; break; case 17: tb = 896; break; case 18: tb = 1024; break; case 24: tb = 1152; break; default: break; }
            const bool wantN = !(g == 4 || g == 5 || g == 8 || g == 9 || g == 17 || g == 18 || g == 24 || g == 25);
            if (wantN) {
#pragma unroll
                for (int ai = 0; ai < 2; ++ai)
#pragma unroll
                    for (int m = 0; m < 4; ++m) {
                        bf16_t* rowp = Z + (size_t)(row0 + ai * HALF + m * 16) * ZW + u.pn * BM + bj * HALF + wc * 32 + 8 * fq;
                        const f32x4 v0 = acc[ai][bj][m][0], v1 = acc[ai][bj][m][1];
                        u32x4 w; w.x = cvtpk(v0[0], v0[1]); w.y = cvtpk(v0[2], v0[3]); w.z = cvtpk(v1[0], v1[1]); w.w = cvtpk(v1[2], v1[3]);
                        *(u32x4*)rowp = w;
                    }
            }
            if (tb >= 0) {
#pragma unroll
                for (int ai = 0; ai < 2; ++ai)
#pragma unroll
                    for (int m = 0; m < 4; ++m) {
                        bf16_t* cp = ZT + (size_t)(tb + wc * 32 + 8 * fq) * T + row0 + ai * HALF + m * 16;
#pragma unroll
                        for (int n = 0; n < 2; ++n)
#pragma unroll
                            for (int e = 0; e < 4; ++e) cp[(size_t)(4 * n + e) * T] = f2bf(acc[ai][bj][m][n][e]);
                    }
            }
        }
    }
};
struct EpiUp {
    static constexpr bool PERM = true;
    const bf16_t* Z; float* part; bf16_t* mix;
    __device__ __forceinline__ void operator()(const f32x4 (&acc)[2][2][4][2], const Unit& u, int wr, int wc, int fr, int fq) const {
        const int row0 = u.pm * BM + wr * 64 + fr, seg = u.e;
#pragma unroll
        for (int ai = 0; ai < 2; ++ai)
#pragma unroll
            for (int m = 0; m < 4; ++m) {
                const int r = row0 + ai * HALF + m * 16;
#pragma unroll
                for (int bj = 0; bj < 2; ++bj) {
                    const int c0 = u.pn * BM + bj * HALF + wc * 32 + 8 * fq;
                    const u32x4 gz = *(const u32x4*)(Z + (size_t)r * ZW + C_MERGE + seg * 1024 + c0);
                    float gv[8];
                    gv[0] = __uint_as_float(gz.x << 16); gv[1] = __uint_as_float(gz.x & 0xffff0000u); gv[2] = __uint_as_float(gz.y << 16); gv[3] = __uint_as_float(gz.y & 0xffff0000u);
                    gv[4] = __uint_as_float(gz.z << 16); gv[5] = __uint_as_float(gz.z & 0xffff0000u); gv[6] = __uint_as_float(gz.w << 16); gv[7] = __uint_as_float(gz.w & 0xffff0000u);
                    float v[8];
#pragma unroll
                    for (int e = 0; e < 4; ++e) { v[e] = sigmoidf_(gv[e]) * acc[ai][bj][m][0][e]; v[4 + e] = sigmoidf_(gv[4 + e]) * acc[ai][bj][m][1][e]; }
                    float* pp = part + (size_t)r * DM + c0;
                    if (seg > 0) { const f32x4 p0 = *(const f32x4*)pp, p1 = *(const f32x4*)(pp + 4);
#pragma unroll
                        for (int e = 0; e < 4; ++e) { v[e] += p0[e]; v[4 + e] += p1[e]; } }
                    if (seg < 3) { *(f32x4*)pp = (f32x4){v[0], v[1], v[2], v[3]}; *(f32x4*)(pp + 4) = (f32x4){v[4], v[5], v[6], v[7]}; }
                    else { u32x4 w; w.x = cvtpk(v[0], v[1]); w.y = cvtpk(v[2], v[3]); w.z = cvtpk(v[4], v[5]); w.w = cvtpk(v[6], v[7]); *(u32x4*)(mix + (size_t)r * DM + c0) = w; }
                    __builtin_amdgcn_sched_barrier(0);
                }
            }
    }
};
struct EpiOut {
    static constexpr bool PERM = false;
    const float* xin; float* xout; const float* gate;
    __device__ __forceinline__ void operator()(const f32x4 (&acc)[2][2][4][2], const Unit& u, int wr, int wc, int fr, int fq) const {
        const int row0 = u.pm * BM + wr * 64 + fr; const float* gp = gate + (size_t)(u.pm >> 3) * 6144;
#pragma unroll
        for (int ai = 0; ai < 2; ++ai)
#pragma unroll
            for (int m = 0; m < 4; ++m) {
                const int r = row0 + ai * HALF + m * 16;
#pragma unroll
                for (int bj = 0; bj < 2; ++bj)
#pragma unroll
                    for (int n = 0; n < 2; ++n) {
                        const int c = u.pn * BM + bj * HALF + wc * 32 + 16 * n + 4 * fq;
                        const f32x4 xv = *(const f32x4*)(xin + (size_t)r * DM + c), gv = *(const f32x4*)(gp + c);
                        *(f32x4*)(xout + (size_t)r * DM + c) = xv + gv * acc[ai][bj][m][n];
                    }
            }
    }
};
struct EpiMoe1 {
    static constexpr bool PERM = true;
    bf16_t* act; const float* bgu;
    __device__ __forceinline__ void operator()(const f32x4 (&acc)[2][2][4][2], const Unit& u, int wr, int wc, int fr, int fq) const {
        const int row0 = u.pm * BM + wr * 64 + fr, col8 = u.pn * 128 + wc * 32 + 8 * fq; const float* bp = bgu + (size_t)u.e * 2048 + col8;
        float bg[8], bl[8];
#pragma unroll
        for (int e = 0; e < 8; ++e) { bg[e] = bp[e]; bl[e] = bp[1024 + e]; }
#pragma unroll
        for (int ai = 0; ai < 2; ++ai)
#pragma unroll
            for (int m = 0; m < 4; ++m) {
                float v[8];
#pragma unroll
                for (int n = 0; n < 2; ++n)
#pragma unroll
                    for (int e = 0; e < 4; ++e) {
                        float gl = acc[ai][0][m][n][e] + bg[4 * n + e], li = acc[ai][1][m][n][e] + bl[4 * n + e];
                        gl = fminf(gl, 7.0f); li = fminf(fmaxf(li, -7.0f), 7.0f);
                        v[4 * n + e] = gl * sigmoidf_(1.702f * gl) * (li + 1.0f);
                    }
                u32x4 w; w.x = cvtpk(v[0], v[1]); w.y = cvtpk(v[2], v[3]); w.z = cvtpk(v[4], v[5]); w.w = cvtpk(v[6], v[7]);
                *(u32x4*)(act + (size_t)(row0 + ai * HALF + m * 16) * DM + col8) = w;
            }
    }
};
struct EpiMoe2 {
    static constexpr bool PERM = true;
    bf16_t* yb; const float* bdn; const float* lw;
    __device__ __forceinline__ void operator()(const f32x4 (&acc)[2][2][4][2], const Unit& u, int wr, int wc, int fr, int fq) const {
#pragma unroll
        for (int ai = 0; ai < 2; ++ai)
#pragma unroll
            for (int m = 0; m < 4; ++m) {
                const int lr = wr * 64 + fr + ai * HALF + m * 16;
                const float w = (lr < u.rows) ? lw[(size_t)u.e * T + u.l0 + lr] : 0.f;
#pragma unroll
                for (int bj = 0; bj < 2; ++bj) {
                    const int c0 = u.pn * BM + bj * HALF + wc * 32 + 8 * fq; const float* bp = bdn + (size_t)u.e * 1024 + c0;
                    const f32x4 b0 = *(const f32x4*)bp, b1 = *(const f32x4*)(bp + 4);
                    const f32x4 v0 = (acc[ai][bj][m][0] + b0) * w, v1 = (acc[ai][bj][m][1] + b1) * w;
                    u32x4 o; o.x = cvtpk(v0[0], v0[1]); o.y = cvtpk(v0[2], v0[3]); o.z = cvtpk(v1[0], v1[1]); o.w = cvtpk(v1[2], v1[3]);
                    *(u32x4*)(yb + (size_t)(u.pm * BM + lr) * DM + c0) = o;
                }
            }
    }
};
}

#define XB_TMO      128
#define XB_XCNT(j)  (256  + 64 * (j))
#define XB_XSUB(j)  (1280 + 64 * (j))
#define XB_XGEN(j)  (2304 + 64 * (j))
#define XB_TOP      3328
#define XB_TOPGEN   3392
#define XCD_BAR_WORDS 3456
#define XB_SPIN_CAP (1u << 18)
__device__ __forceinline__ unsigned xb_ld(unsigned* p)              { return __hip_atomic_load(p, __ATOMIC_RELAXED, __HIP_MEMORY_SCOPE_AGENT); }
__device__ __forceinline__ unsigned xb_add(unsigned* p, unsigned v) { return __hip_atomic_fetch_add(p, v, __ATOMIC_RELAXED, __HIP_MEMORY_SCOPE_AGENT); }
__device__ __forceinline__ unsigned xb_xcc_id() { return (unsigned)__builtin_amdgcn_s_getreg((3 << 11) | 20) & 0xFu; }
#define XB_SPIN(cond, bar) do { unsigned _sp = 0; while (cond) { __builtin_amdgcn_s_sleep(1); \
    if ((++_sp & 255u) == 0u) { if (xb_ld(&(bar)[XB_TMO])) break; if (_sp > XB_SPIN_CAP) { atomicAdd(&(bar)[XB_TMO], 1u); break; } } } } while (0)
struct XcdBarrier { unsigned* bar; unsigned x; volatile LAS unsigned* st; };
__device__ __forceinline__ XcdBarrier xcd_barrier_post(unsigned* bar, volatile LAS unsigned* st) {
    XcdBarrier b; b.bar = bar; b.x = xb_xcc_id(); b.st = st;
    if (threadIdx.x == 0) (void)xb_add(&bar[XB_XCNT(b.x)], 1u);
    return b;
}
__device__ __forceinline__ void xcd_barrier_complete(unsigned* bar, unsigned x, unsigned& nloc, unsigned& nx) {
    const unsigned G = gridDim.x * gridDim.y * gridDim.z;
    unsigned sum, cnt, mine, sp = 0u;
    for (;;) {
        sum = 0u; cnt = 0u; mine = 0u;
#pragma unroll
        for (unsigned j = 0; j < 16; ++j) { const unsigned c = xb_ld(&bar[XB_XCNT(j)]); sum += c; cnt += (c > 0u) ? 1u : 0u; mine = (j == x) ? c : mine; }
        if (sum == G) break;
        __builtin_amdgcn_s_sleep(1);
        if ((++sp & 255u) == 0u) { if (xb_ld(&bar[XB_TMO])) break; if (sp > XB_SPIN_CAP) { atomicAdd(&bar[XB_TMO], 1u); break; } }
    }
    nloc = mine > 0u ? mine : 1u; nx = cnt > 0u ? cnt : 1u;
}
__device__ __forceinline__ void xcd_barrier(const XcdBarrier& b) {
    asm volatile("s_waitcnt vmcnt(0)" ::: "memory");
    __syncthreads();
    if (threadIdx.x == 0) {
        unsigned* bar = b.bar;
        __builtin_amdgcn_s_waitcnt(0);
        unsigned nloc = b.st[0], nx = b.st[1];
        if (nloc == 0u) { xcd_barrier_complete(bar, b.x, nloc, nx); b.st[0] = nloc; b.st[1] = nx; }
        const unsigned old = xb_add(&bar[XB_XSUB(b.x)], 1u);
        const unsigned gen = old / nloc;
        if (old + 1u == (gen + 1u) * nloc) {
            __builtin_amdgcn_fence(__ATOMIC_RELEASE, "agent");
            asm volatile("s_waitcnt vmcnt(0)" ::: "memory");
            const unsigned og = xb_add(&bar[XB_TOP], 1u);
            const unsigned tg = og / nx;
            if (og + 1u == (tg + 1u) * nx) xb_add(&bar[XB_TOPGEN], 1u);
            else XB_SPIN(xb_ld(&bar[XB_TOPGEN]) == tg, bar);
            __builtin_amdgcn_fence(__ATOMIC_ACQUIRE, "agent");
            xb_add(&bar[XB_XGEN(b.x)], 1u);
            asm volatile("s_waitcnt vmcnt(0)" ::: "memory");
        } else {
            XB_SPIN(xb_ld(&bar[XB_XGEN(b.x)]) == gen, bar);
            __builtin_amdgcn_fence(__ATOMIC_ACQUIRE, "agent");
            asm volatile("s_waitcnt vmcnt(0)" ::: "memory");
        }
    }
    __syncthreads();
}

struct Frame {
    LAS unsigned char* lds;
    unsigned* ctl;
    int tid, lane, wave, vcu, G;
    const float *x, *c, *w_ada, *b_ada, *g_mix, *w_in, *w_gg, *b_gg, *g_gla, *g_ret, *sinks, *w_br, *w_out, *g_ffn, *w_rt, *b_rt, *w_gu, *b_gu, *w_dn, *b_dn, *g_fin;
    float* out;
    float *MOD, *KMEAN, *LW, *KVG, *DECG, *KVR, *BCUM, *PART, *X1, *X2;
    int *SELE, *SELP, *LTOK;
    bf16 *WIN, *WBR, *WOUT, *WGU, *WDN, *H, *Z, *ZT, *YS, *MIX, *ACT, *YB;
};

__device__ __forceinline__ void tr_item(const float* W, int ldsrc, int k0, int scol0, bf16* WT, int ldk, int drow0, LAS float* scr, int lane) {
    float tmp[32];
#pragma unroll
    for (int i = 0; i < 32; ++i) { const int kk = 2 * i + (lane >> 5); tmp[i] = W[(size_t)(k0 + kk) * ldsrc + scol0 + (lane & 31)]; }
#pragma unroll
    for (int i = 0; i < 32; ++i) { const int kk = 2 * i + (lane >> 5); scr[kk * 33 + (lane & 31)] = tmp[i]; }
    __builtin_amdgcn_wave_barrier();
    asm volatile("s_waitcnt lgkmcnt(0)" ::: "memory");
    const int c = lane & 7;
#pragma unroll
    for (int j = 0; j < 4; ++j) { const int n = (lane >> 3) + 8 * j; const LAS float* s = scr + (8 * c) * 33 + n;
        u32x4 o; o.x = cvtpk(s[0 * 33], s[1 * 33]); o.y = cvtpk(s[2 * 33], s[3 * 33]); o.z = cvtpk(s[4 * 33], s[5 * 33]); o.w = cvtpk(s[6 * 33], s[7 * 33]);
        *(u32x4*)(WT + (size_t)(drow0 + n) * ldk + k0 + 8 * c) = o; }
    asm volatile("s_waitcnt lgkmcnt(0)" ::: "memory");
    __builtin_amdgcn_wave_barrier();
}

__device__ __forceinline__ void p0_prologue(Frame& F) {
    {
        LAS float* cact = (LAS float*)(F.lds);
        LAS float* red = (LAS float*)(F.lds + 32768);
        if (F.vcu < 192) {
            for (int i = F.tid; i < 8 * 1024; i += 512) cact[i] = siluf_(F.c[i]);
            __syncthreads();
            for (int wt = F.vcu; wt < 192; wt += F.G) {
                const int l = wt / 96, j = (wt % 96) * 64 + F.lane;
                float a[8];
#pragma unroll
                for (int b = 0; b < 8; ++b) a[b] = 0.f;
                const float* wp = F.w_ada + ((size_t)l * 1024 + F.wave * 128) * 6144 + j;
#pragma unroll 8
                for (int k = 0; k < 128; ++k) { const float w = wp[(size_t)k * 6144];
#pragma unroll
                    for (int b = 0; b < 8; ++b) a[b] += cact[b * 1024 + F.wave * 128 + k] * w; }
#pragma unroll
                for (int b = 0; b < 8; ++b) red[(F.wave * 8 + b) * 64 + F.lane] = a[b];
                __syncthreads();
                { const int b = F.wave; float s = 0.f;
#pragma unroll
                  for (int w = 0; w < 8; ++w) s += red[(w * 8 + b) * 64 + F.lane];
                  F.MOD[(size_t)(l * 8 + b) * 6144 + j] = s + F.b_ada[l * 6144 + j]; }
                __syncthreads();
            }
        }
        __syncthreads();
    }
    LAS float* scr = (LAS float*)(F.lds + F.wave * 16384);
    const int gw = F.vcu * NWAVES + F.wave, NGW = F.G * NWAVES;
    constexpr int I_IN = 2 * 232 * 16, I_BR = 2 * 4 * 4 * 32, I_OUT = 2 * 16 * 32, I_GU = 64 * 16 * 64, I_DN = 64 * 16 * 32, I_FOLD = 2 * 16, I_PAD = 2 * 128;
    constexpr int NITEMS = I_IN + I_BR + I_OUT + I_GU + I_DN + I_FOLD + I_PAD;
    for (int it = gw; it < NITEMS; it += NGW) {
        int r = it;
        if (r < I_IN) { const int l = r / (232 * 16), q = r % (232 * 16), kb = q / 232, nb = q % 232, c = nb * 32;
            int sc; if (c < 1280) sc = c; else if (c < 1408) continue; else if (c < 3200) sc = c - 112; else if (c < 3328) continue; else sc = c - 240;
            tr_item(F.w_in + (size_t)l * 1024 * DIN, DIN, kb * 64, sc, F.WIN + (size_t)l * (WIN_STRIDE / 2), 1024, c, scr, F.lane); continue; }
        r -= I_IN;
        if (r < I_BR) { const int ln = r / 128, q = r % 128, kb = q / 32, nb = q % 32;
            tr_item(F.w_br + (size_t)ln * 256 * 1024, 1024, kb * 64, nb * 32, F.WBR + (size_t)ln * 1024 * 256, 256, nb * 32, scr, F.lane); continue; }
        r -= I_BR;
        if (r < I_OUT) { const int l = r / 512, q = r % 512, kb = q / 32, nb = q % 32;
            tr_item(F.w_out + (size_t)l * 1024 * 1024, 1024, kb * 64, nb * 32, F.WOUT + (size_t)l * 1024 * 1024, 1024, nb * 32, scr, F.lane); continue; }
        r -= I_OUT;
        if (r < I_GU) { const int le = r / 1024, q = r % 1024, kb = q / 64, nb = q % 64, pn = nb >> 3, rr = (nb & 7) * 32, bj = rr >> 7, r0 = rr & 127;
            tr_item(F.w_gu + (size_t)le * 1024 * 2048, 2048, kb * 64, bj * 1024 + pn * 128 + r0, F.WGU + (size_t)le * 2048 * 1024, 1024, nb * 32, scr, F.lane); continue; }
        r -= I_GU;
        if (r < I_DN) { const int le = r / 512, q = r % 512, kb = q / 32, nb = q % 32;
            tr_item(F.w_dn + (size_t)le * 1024 * 1024, 1024, kb * 64, nb * 32, F.WDN + (size_t)le * 1024 * 1024, 1024, nb * 32, scr, F.lane); continue; }
        r -= I_DN;
        if (r < I_FOLD) {
            const int l = r / 16, k = (r % 16) * 64 + F.lane;
            float a[16];
            const float* ap = F.w_in + ((size_t)l * 1024 + k) * DIN + 1280;
#pragma unroll
            for (int q = 0; q < 16; ++q) a[q] = ap[q];
            const float* wg = F.w_gg + (size_t)l * 16 * 128;
            bf16* dst = F.WIN + (size_t)l * (WIN_STRIDE / 2) + (size_t)C_GLOG * 1024 + k;
            for (int j = 0; j < 128; ++j) { float s = 0.f;
#pragma unroll
                for (int q = 0; q < 16; ++q) s += a[q] * wg[q * 128 + j];
                dst[(size_t)j * 1024] = f2bf(s); }
            continue; }
        r -= I_FOLD;
        { const int l = r / 128, row = C_PAD + (r % 128);
          u32x4* dst = (u32x4*)(F.WIN + (size_t)l * (WIN_STRIDE / 2) + (size_t)row * 1024);
          dst[F.lane] = (u32x4){0u, 0u, 0u, 0u}; dst[64 + F.lane] = (u32x4){0u, 0u, 0u, 0u}; }
    }
}

__device__ __forceinline__ void row_load(const float* p, int lane, f32x4 (&v)[4]) {
#pragma unroll
    for (int j = 0; j < 4; ++j) v[j] = *(const f32x4*)(p + 4 * lane + 256 * j);
}
__device__ __forceinline__ float row_rinv(const f32x4 (&v)[4]) {
    float s = 0.f;
#pragma unroll
    for (int j = 0; j < 4; ++j) s += (v[j][0] * v[j][0] + v[j][1] * v[j][1]) + (v[j][2] * v[j][2] + v[j][3] * v[j][3]);
    return 1.0f / sqrtf(wave_sum(s) * (1.0f / DM) + NORM_EPS);
}
__device__ __forceinline__ void row_adaln(f32x4 (&v)[4], float rinv, const float* g, const float* scale, const float* shift, int lane, bf16* orow) {
#pragma unroll
    for (int j = 0; j < 4; ++j) {
        const int c = 4 * lane + 256 * j;
        const f32x4 gv = *(const f32x4*)(g + c), sc = *(const f32x4*)(scale + c), sh = *(const f32x4*)(shift + c);
        v[j] = v[j] * rinv * gv * (sc + 1.0f) + sh;
        u32x2 w; w.x = cvtpk(v[j][0], v[j][1]); w.y = cvtpk(v[j][2], v[j][3]);
        *(u32x2*)(orow + c) = w;
    }
}

__device__ __forceinline__ void p1_norm(Frame& F) {
    const int gw = F.vcu * NWAVES + F.wave, NGW = F.G * NWAVES;
    for (int t = gw; t < T; t += NGW) {
        f32x4 v[4]; row_load(F.x + (size_t)t * DM, F.lane, v);
        const float ri = row_rinv(v); const float* mp = F.MOD + (size_t)(t >> 11) * 6144;
        row_adaln(v, ri, F.g_mix, mp + 1024, mp, F.lane, F.H + (size_t)t * DM);
    }
}

__device__ __forceinline__ void kmean_task(Frame& F, int id) {
    const int j = id & 7, bh = id >> 3, b = bh >> 2, h = bh & 3;
    const bf16* p = F.Z + (size_t)(b * SEQ + j * 256) * ZW + C_MK + h * 64 + F.lane;
    float s = 0.f;
#pragma unroll 16
    for (int t = 0; t < 256; ++t) s += bf2f(p[(size_t)t * ZW]);
    F.KMEAN[(size_t)id * 64 + F.lane] = s * (1.0f / 256.0f);
}
__device__ __forceinline__ void ret_state_task(Frame& F, int id) {
    const int n = id & 31, bh = id >> 5, b = bh >> 2, h = bh & 3, r = F.lane & 31, hh = F.lane >> 5;
    const size_t tg0 = (size_t)b * SEQ + n * 64;
    const float lg = __log2f(1.0f - fexp2(-(float)(5 + h)));
    bf16x8 vf[2][4], kd[2][4];
#pragma unroll
    for (int dt = 0; dt < 2; ++dt)
#pragma unroll
        for (int s = 0; s < 4; ++s) vf[dt][s] = ld8(F.ZT + (size_t)(ZT_VR + h * 64 + dt * 32 + r) * T + tg0 + 16 * s + 8 * hh);
#pragma unroll
    for (int dk = 0; dk < 2; ++dk)
#pragma unroll
        for (int s = 0; s < 4; ++s) {
            const bf16x8 raw = ld8(F.ZT + (size_t)(ZT_KR + h * 64 + dk * 32 + r) * T + tg0 + 16 * s + 8 * hh);
            float f[8];
#pragma unroll
            for (int jj = 0; jj < 8; ++jj) { const int j = 16 * s + 8 * hh + jj; f[jj] = bf2f((unsigned short)raw[jj]) * fexp2((float)(63 - j) * lg) * 0.125f; }
            kd[dk][s] = pack8(f);
        }
    float* op = F.KVR + (size_t)id * 4096;
#pragma unroll
    for (int dt = 0; dt < 2; ++dt)
#pragma unroll
        for (int dk = 0; dk < 2; ++dk) {
            f32x16 a; for (int i = 0; i < 16; ++i) a[i] = 0.f;
#pragma unroll
            for (int s = 0; s < 4; ++s) a = MFMA32(vf[dt][s], kd[dk][s], a);
#pragma unroll
            for (int i = 0; i < 16; ++i) op[(dt * 32 + crow(i, hh)) * 64 + dk * 32 + r] = a[i];
        }
}
__device__ __forceinline__ void gla_state_task(Frame& F, int l, int id) {
    const int n = id & 31, bh = id >> 5, b = bh >> 2, h = bh & 3, r = F.lane & 31, hh = F.lane >> 5;
    const size_t tg0 = (size_t)b * SEQ + n * 64;
    const float bias = F.b_gg[l * 128 + h * 32 + r];
    float bb[4][8], tot[4], ptot[4];
#pragma unroll
    for (int s = 0; s < 4; ++s) {
        float run = 0.f;
#pragma unroll
        for (int jj = 0; jj < 8; ++jj) {
            const float xg = bf2f(F.Z[(tg0 + 16 * s + 8 * hh + jj) * ZW + C_GLOG + h * 32 + r]) + bias;
            const float la = (fminf(xg, 0.f) - log1pf(__expf(-fabsf(xg)))) * (1.0f / 16.0f);
            run += la; bb[s][jj] = run;
        }
        tot[s] = run;
    }
#pragma unroll
    for (int s = 0; s < 4; ++s) ptot[s] = __shfl_xor(tot[s], 32);
    float off = 0.f;
#pragma unroll
    for (int s = 0; s < 4; ++s) {
        const float my = off + (hh ? ptot[s] : 0.f);
#pragma unroll
        for (int jj = 0; jj < 8; ++jj) bb[s][jj] += my;
        off += tot[s] + ptot[s];
    }
    const float bend = off;
#pragma unroll
    for (int s = 0; s < 4; ++s)
#pragma unroll
        for (int jj = 0; jj < 8; ++jj) F.BCUM[(tg0 + 16 * s + 8 * hh + jj) * 128 + h * 32 + r] = bb[s][jj];
    if (hh == 0) F.DECG[(size_t)id * 32 + r] = __expf(bend);
    bf16x8 kd[4], vf[2][4];
#pragma unroll
    for (int s = 0; s < 4; ++s) {
        const bf16x8 raw = ld8(F.ZT + (size_t)(ZT_KG + h * 32 + r) * T + tg0 + 16 * s + 8 * hh);
        float f[8];
#pragma unroll
        for (int jj = 0; jj < 8; ++jj) f[jj] = bf2f((unsigned short)raw[jj]) * __expf(bend - bb[s][jj]);
        kd[s] = pack8(f);
    }
#pragma unroll
    for (int dt = 0; dt < 2; ++dt)
#pragma unroll
        for (int s = 0; s < 4; ++s) vf[dt][s] = ld8(F.ZT + (size_t)(ZT_VG + h * 64 + dt * 32 + r) * T + tg0 + 16 * s + 8 * hh);
    float* op = F.KVG + (size_t)id * 2048;
#pragma unroll
    for (int dt = 0; dt < 2; ++dt) {
        f32x16 a; for (int i = 0; i < 16; ++i) a[i] = 0.f;
#pragma unroll
        for (int s = 0; s < 4; ++s) a = MFMA32(vf[dt][s], kd[s], a);
#pragma unroll
        for (int i = 0; i < 16; ++i) op[(dt * 32 + crow(i, hh)) * 32 + r] = a[i];
    }
}
__device__ __forceinline__ void p3a_states(Frame& F, int l) {
    const int gw = F.vcu * NWAVES + F.wave, NGW = F.G * NWAVES;
    for (int it = gw; it < 256 + 1024 + 1024; it += NGW) {
        if (it < 1024) ret_state_task(F, it);
        else if (it < 2048) gla_state_task(F, l, it - 1024);
        else kmean_task(F, it - 2048);
    }
}

struct AttnSt { f32x16 O0, O1; float m, l; };
constexpr float NEG_BIG = -1.0e30f;
template <int MODE>
__device__ __forceinline__ void attn_tile(AttnSt& st, const bf16x8 (&qf)[4], const bf16* Kb, const bf16* Vt, int key0, int qpos, int r, int hh, float c1, float sl2, bool sel) {
    const bf16* kp = Kb + (size_t)(key0 + swap23(r)) * ZW + 8 * hh;
    bf16x8 kf[4], vf[2][2];
#pragma unroll
    for (int kk = 0; kk < 4; ++kk) kf[kk] = ld8(kp + 16 * kk);
#pragma unroll
    for (int dt = 0; dt < 2; ++dt)
#pragma unroll
        for (int s = 0; s < 2; ++s) vf[dt][s] = ld8(Vt + (size_t)(dt * 32 + r) * T + key0 + 16 * s + 8 * hh);
    f32x16 S; for (int i = 0; i < 16; ++i) S[i] = 0.f;
#pragma unroll
    for (int kk = 0; kk < 4; ++kk) S = MFMA32(kf[kk], qf[kk], S);
    float sv[16]; float mx = NEG_BIG;
#pragma unroll
    for (int i = 0; i < 16; ++i) {
        const int kpos = key0 + 8 * hh + (i & 7) + 16 * (i >> 3); const int dist = qpos - kpos;
        float s = S[i] * c1 - sl2 * (float)dist;
        bool valid = true;
        if (MODE == 1) valid = dist >= 0; else if (MODE == 2) valid = dist < 128; else if (MODE == 3) valid = sel;
        s = valid ? s : NEG_BIG; sv[i] = s; mx = fmaxf(mx, s);
    }
    mx = fmaxf(mx, __shfl_xor(mx, 32));
    const float mnew = fmaxf(st.m, mx), alpha = fexp2(st.m - mnew);
    float ls = 0.f;
#pragma unroll
    for (int i = 0; i < 16; ++i) { const float p = fexp2(sv[i] - mnew); sv[i] = p; ls += p; }
    st.l = st.l * alpha + ls; st.m = mnew;
#pragma unroll
    for (int i = 0; i < 16; ++i) { st.O0[i] *= alpha; st.O1[i] *= alpha; }
    const bf16x8 p0 = pack8(sv), p1 = pack8(sv + 8);
    st.O0 = MFMA32(vf[0][0], p0, st.O0); st.O0 = MFMA32(vf[0][1], p1, st.O0);
    st.O1 = MFMA32(vf[1][0], p0, st.O1); st.O1 = MFMA32(vf[1][1], p1, st.O1);
}
__device__ __forceinline__ void attn_store(const AttnSt& st, float denom, bf16* orow  , int hh) {
    const float inv = 1.0f / denom;
#pragma unroll
    for (int g4 = 0; g4 < 4; ++g4) {
        u32x2 w0, w1;
        w0.x = cvtpk(st.O0[4 * g4] * inv, st.O0[4 * g4 + 1] * inv); w0.y = cvtpk(st.O0[4 * g4 + 2] * inv, st.O0[4 * g4 + 3] * inv);
        w1.x = cvtpk(st.O1[4 * g4] * inv, st.O1[4 * g4 + 1] * inv); w1.y = cvtpk(st.O1[4 * g4 + 2] * inv, st.O1[4 * g4 + 3] * inv);
        *(u32x2*)(orow + 8 * g4 + 4 * hh) = w0; *(u32x2*)(orow + 32 + 8 * g4 + 4 * hh) = w1;
    }
}
__device__ __forceinline__ void moba_task(Frame& F, int b, int h, int qt) {
    const int r = F.lane & 31, hh = F.lane >> 5, q0 = qt * 32, blk = q0 >> 8, qpos = q0 + r;
    const bf16* Zb = F.Z + (size_t)(b * SEQ) * ZW;
    bf16x8 qf[4];
#pragma unroll
    for (int kk = 0; kk < 4; ++kk) qf[kk] = ld8(Zb + (size_t)qpos * ZW + C_MQ + h * 64 + 16 * kk + 8 * hh);
    float g[7];
#pragma unroll
    for (int j = 0; j < 7; ++j) {
        float p = -INFINITY;
        if (j < blk) {
            const float* km = F.KMEAN + (size_t)((b * 4 + h) * 8 + j) * 64 + 8 * hh; p = 0.f;
#pragma unroll
            for (int kk = 0; kk < 4; ++kk) { const f32x4 a = *(const f32x4*)(km + 16 * kk), c = *(const f32x4*)(km + 16 * kk + 4);
#pragma unroll
                for (int e = 0; e < 4; ++e) p += bf2f((unsigned short)qf[kk][e]) * a[e] + bf2f((unsigned short)qf[kk][4 + e]) * c[e]; }
            p += __shfl_xor(p, 32);
        }
        g[j] = p;
    }
    unsigned selmask = 1u << blk;
    const int nsel = blk < 3 ? blk : 3;
#pragma unroll
    for (int rd = 0; rd < 3; ++rd) {
        if (rd < nsel) {
            int best = 0; float bv = g[0];
#pragma unroll
            for (int j = 1; j < 7; ++j) if (g[j] > bv) { bv = g[j]; best = j; }
            selmask |= 1u << best;
#pragma unroll
            for (int j = 0; j < 7; ++j) if (j == best) g[j] = -INFINITY;
        }
    }
    AttnSt st; for (int i = 0; i < 16; ++i) { st.O0[i] = 0.f; st.O1[i] = 0.f; } st.m = NEG_BIG; st.l = 0.f;
    const float c1 = 0.125f * LOG2E, sl2 = fexp2(-(float)(5 + h)) * LOG2E;
    const bf16* Kb = Zb + C_MK + h * 64;
    const bf16* Vt = F.ZT + (size_t)(ZT_VM + h * 64) * T + (size_t)b * SEQ;
    attn_tile<1>(st, qf, Kb, Vt, q0, qpos, r, hh, c1, sl2, true);
    for (int kt = blk * 8; kt < qt; ++kt) attn_tile<0>(st, qf, Kb, Vt, kt * 32, qpos, r, hh, c1, sl2, true);
    for (int j = 0; j < blk; ++j) {
        const bool sel = (selmask >> j) & 1u;
        if (__ballot(sel) == 0ull) continue;
        for (int kt = 0; kt < 8; ++kt) attn_tile<3>(st, qf, Kb, Vt, j * 256 + kt * 32, qpos, r, hh, c1, sl2, sel);
    }
    const float lt = st.l + __shfl_xor(st.l, 32);
    attn_store(st, lt, F.YS + (size_t)(b * SEQ + qpos) * DM + 0 + h * 64, hh);
}
__device__ __forceinline__ void swa_task(Frame& F, int l, int b, int hq, int qt) {
    const int r = F.lane & 31, hh = F.lane >> 5, q0 = qt * 32, qpos = q0 + r, kvh = hq >> 1;
    const bf16* Zb = F.Z + (size_t)(b * SEQ) * ZW;
    bf16x8 qf[4];
#pragma unroll
    for (int kk = 0; kk < 4; ++kk) qf[kk] = ld8(Zb + (size_t)qpos * ZW + C_SQ + hq * 64 + 16 * kk + 8 * hh);
    AttnSt st; for (int i = 0; i < 16; ++i) { st.O0[i] = 0.f; st.O1[i] = 0.f; } st.m = NEG_BIG; st.l = 0.f;
    const float c1 = 0.125f * LOG2E, sl2 = fexp2(-(float)(1 + hq)) * LOG2E;
    const bf16* Kb = Zb + C_SK + kvh * 64;
    const bf16* Vt = F.ZT + (size_t)(ZT_VS + kvh * 64) * T + (size_t)b * SEQ;
    attn_tile<1>(st, qf, Kb, Vt, q0, qpos, r, hh, c1, sl2, true);
    for (int d = 1; d <= 3; ++d) { const int k0 = q0 - 32 * d; if (k0 >= 0) attn_tile<0>(st, qf, Kb, Vt, k0, qpos, r, hh, c1, sl2, true); }
    if (q0 - 128 >= 0) attn_tile<2>(st, qf, Kb, Vt, q0 - 128, qpos, r, hh, c1, sl2, true);
    const float lt = st.l + __shfl_xor(st.l, 32);
    const float ps = fexp2(F.sinks[l * 4 + hq] * LOG2E - st.m);
    attn_store(st, lt + ps, F.YS + (size_t)(b * SEQ + qpos) * DM + 768 + hq * 64, hh);
}
__device__ __forceinline__ void ret_task(Frame& F, int l, int b, int h, int n) {
    const int r = F.lane & 31, hh = F.lane >> 5;
    const size_t tg = (size_t)b * SEQ + n * 64;
    const float lg = __log2f(1.0f - fexp2(-(float)(5 + h))), g64 = fexp2(64.0f * lg);
    float stt[2][4][8];
#pragma unroll
    for (int dt = 0; dt < 2; ++dt)
#pragma unroll
        for (int kk = 0; kk < 4; ++kk)
#pragma unroll
            for (int j = 0; j < 8; ++j) stt[dt][kk][j] = 0.f;
    const float* kv = F.KVR + (size_t)((b * 4 + h) * 32) * 4096;
    for (int m = 0; m < n; ++m) {
#pragma unroll
        for (int dt = 0; dt < 2; ++dt)
#pragma unroll
            for (int kk = 0; kk < 4; ++kk) {
                const float* p = kv + (size_t)m * 4096 + (dt * 32 + r) * 64 + 16 * kk + 8 * hh;
                const f32x4 a = *(const f32x4*)p, c = *(const f32x4*)(p + 4);
#pragma unroll
                for (int e = 0; e < 4; ++e) { stt[dt][kk][e] = stt[dt][kk][e] * g64 + a[e]; stt[dt][kk][4 + e] = stt[dt][kk][4 + e] * g64 + c[e]; }
            }
    }
    bf16x8 sf[2][4];
#pragma unroll
    for (int dt = 0; dt < 2; ++dt)
#pragma unroll
        for (int kk = 0; kk < 4; ++kk) sf[dt][kk] = pack8(stt[dt][kk]);
    const bf16* Zr = F.Z + tg * ZW;
#pragma unroll
    for (int qt = 0; qt < 2; ++qt) {
        const int i = qt * 32 + r;
        bf16x8 qf[4];
#pragma unroll
        for (int kk = 0; kk < 4; ++kk) qf[kk] = ld8(Zr + (size_t)i * ZW + C_RQ + h * 64 + 16 * kk + 8 * hh);
        f32x16 O[2];
#pragma unroll
        for (int dt = 0; dt < 2; ++dt) { for (int e = 0; e < 16; ++e) O[dt][e] = 0.f;
#pragma unroll
            for (int kk = 0; kk < 4; ++kk) O[dt] = MFMA32(sf[dt][kk], qf[kk], O[dt]); }
        const float gi = fexp2((float)(i + 1) * lg);
#pragma unroll
        for (int e = 0; e < 16; ++e) { O[0][e] *= gi; O[1][e] *= gi; }
#pragma unroll
        for (int kt = 0; kt <= qt; ++kt) {
            bf16x8 kf[4], vf[2][2];
#pragma unroll
            for (int kk = 0; kk < 4; ++kk) kf[kk] = ld8(Zr + (size_t)(kt * 32 + swap23(r)) * ZW + C_RK + h * 64 + 16 * kk + 8 * hh);
#pragma unroll
            for (int dt = 0; dt < 2; ++dt)
#pragma unroll
                for (int s = 0; s < 2; ++s) vf[dt][s] = ld8(F.ZT + (size_t)(ZT_VR + h * 64 + dt * 32 + r) * T + tg + kt * 32 + 16 * s + 8 * hh);
            f32x16 A; for (int e = 0; e < 16; ++e) A[e] = 0.f;
#pragma unroll
            for (int kk = 0; kk < 4; ++kk) A = MFMA32(kf[kk], qf[kk], A);
            float a[16];
#pragma unroll
            for (int e = 0; e < 16; ++e) { const int j = kt * 32 + 8 * hh + (e & 7) + 16 * (e >> 3); a[e] = (j <= i) ? A[e] * fexp2((float)(i - j) * lg) * 0.125f : 0.f; }
            const bf16x8 p0 = pack8(a), p1 = pack8(a + 8);
            O[0] = MFMA32(vf[0][0], p0, O[0]); O[0] = MFMA32(vf[0][1], p1, O[0]);
            O[1] = MFMA32(vf[1][0], p0, O[1]); O[1] = MFMA32(vf[1][1], p1, O[1]);
        }
        float s1 = 0.f;
#pragma unroll
        for (int e = 0; e < 16; ++e) s1 += O[0][e] + O[1][e];
        s1 += __shfl_xor(s1, 32);
        const float mean = s1 * (1.0f / 64.0f);
        float s2 = 0.f;
#pragma unroll
        for (int e = 0; e < 16; ++e) { const float d0 = O[0][e] - mean, d1 = O[1][e] - mean; s2 += d0 * d0 + d1 * d1; }
        s2 += __shfl_xor(s2, 32);
        const float rs = 1.0f / sqrtf(s2 * (1.0f / 64.0f) + NORM_EPS);
        const bf16* gp = Zr + (size_t)i * ZW + C_RG + h * 64; const float* gn = F.g_ret + l * 256 + h * 64;
        bf16* op = F.YS + (tg + i) * DM + 512 + h * 64;
#pragma unroll
        for (int dt = 0; dt < 2; ++dt)
#pragma unroll
            for (int g4 = 0; g4 < 4; ++g4) {
                const int d = dt * 32 + 8 * g4 + 4 * hh;
                const u32x2 gz = *(const u32x2*)(gp + d); const f32x4 gg = *(const f32x4*)(gn + d);
                const float z0 = __uint_as_float(gz.x << 16), z1 = __uint_as_float(gz.x & 0xffff0000u), z2 = __uint_as_float(gz.y << 16), z3 = __uint_as_float(gz.y & 0xffff0000u);
                const float y0 = (O[dt][4 * g4] - mean) * rs * gg[0] * siluf_(z0), y1 = (O[dt][4 * g4 + 1] - mean) * rs * gg[1] * siluf_(z1);
                const float y2 = (O[dt][4 * g4 + 2] - mean) * rs * gg[2] * siluf_(z2), y3 = (O[dt][4 * g4 + 3] - mean) * rs * gg[3] * siluf_(z3);
                u32x2 w; w.x = cvtpk(y0, y1); w.y = cvtpk(y2, y3); *(u32x2*)(op + d) = w;
            }
    }
}
__device__ __forceinline__ void gla_task(Frame& F, int l, int b, int h, int n) {
    const int r = F.lane & 31, hh = F.lane >> 5;
    const size_t tg = (size_t)b * SEQ + n * 64;
    float stt[2][2][8];
#pragma unroll
    for (int dt = 0; dt < 2; ++dt)
#pragma unroll
        for (int kk = 0; kk < 2; ++kk)
#pragma unroll
            for (int j = 0; j < 8; ++j) stt[dt][kk][j] = 0.f;
    const size_t bh32 = (size_t)((b * 4 + h) * 32);
    for (int m = 0; m < n; ++m) {
#pragma unroll
        for (int kk = 0; kk < 2; ++kk) {
            const float* dp = F.DECG + (bh32 + m) * 32 + 16 * kk + 8 * hh;
            const f32x4 d0 = *(const f32x4*)dp, d1 = *(const f32x4*)(dp + 4);
#pragma unroll
            for (int dt = 0; dt < 2; ++dt) {
                const float* p = F.KVG + (bh32 + m) * 2048 + (dt * 32 + r) * 32 + 16 * kk + 8 * hh;
                const f32x4 a = *(const f32x4*)p, c = *(const f32x4*)(p + 4);
#pragma unroll
                for (int e = 0; e < 4; ++e) { stt[dt][kk][e] = stt[dt][kk][e] * d0[e] + a[e]; stt[dt][kk][4 + e] = stt[dt][kk][4 + e] * d1[e] + c[e]; }
            }
        }
    }
    bf16x8 sf[2][2];
#pragma unroll
    for (int dt = 0; dt < 2; ++dt)
#pragma unroll
        for (int kk = 0; kk < 2; ++kk) sf[dt][kk] = pack8(stt[dt][kk]);
    const bf16* Zr = F.Z + tg * ZW;
#pragma unroll
    for (int qt = 0; qt < 2; ++qt) {
        const int i = qt * 32 + r;
        bf16x8 qf[2];
#pragma unroll
        for (int kk = 0; kk < 2; ++kk) {
            const bf16x8 raw = ld8(Zr + (size_t)i * ZW + C_GQ + h * 32 + 16 * kk + 8 * hh);
            const float* bp = F.BCUM + (tg + i) * 128 + h * 32 + 16 * kk + 8 * hh;
            const f32x4 b0 = *(const f32x4*)bp, b1 = *(const f32x4*)(bp + 4);
            float f[8];
#pragma unroll
            for (int e = 0; e < 4; ++e) { f[e] = bf2f((unsigned short)raw[e]) * __expf(b0[e]) * 0.17677669529663687f; f[4 + e] = bf2f((unsigned short)raw[4 + e]) * __expf(b1[e]) * 0.17677669529663687f; }
            qf[kk] = pack8(f);
        }
        f32x16 O[2];
#pragma unroll
        for (int dt = 0; dt < 2; ++dt) { for (int e = 0; e < 16; ++e) O[dt][e] = 0.f;
#pragma unroll
            for (int kk = 0; kk < 2; ++kk) O[dt] = MFMA32(sf[dt][kk], qf[kk], O[dt]); }
#pragma unroll
        for (int kt = 0; kt <= qt; ++kt) {
            bf16x8 kf[2], vf[2][2];
            const int jr = kt * 32 + swap23(r);
#pragma unroll
            for (int kk = 0; kk < 2; ++kk) {
                const bf16x8 raw = ld8(Zr + (size_t)jr * ZW + C_GK + h * 32 + 16 * kk + 8 * hh);
                const float* bp = F.BCUM + (tg + jr) * 128 + h * 32 + 16 * kk + 8 * hh;
                const f32x4 b0 = *(const f32x4*)bp, b1 = *(const f32x4*)(bp + 4);
                float f[8];
#pragma unroll
                for (int e = 0; e < 4; ++e) { f[e] = bf2f((unsigned short)raw[e]) * __expf(-b0[e]); f[4 + e] = bf2f((unsigned short)raw[4 + e]) * __expf(-b1[e]); }
                kf[kk] = pack8(f);
            }
#pragma unroll
            for (int dt = 0; dt < 2; ++dt)
#pragma unroll
                for (int s = 0; s < 2; ++s) vf[dt][s] = ld8(F.ZT + (size_t)(ZT_VG + h * 64 + dt * 32 + r) * T + tg + kt * 32 + 16 * s + 8 * hh);
            f32x16 A; for (int e = 0; e < 16; ++e) A[e] = 0.f;
#pragma unroll
            for (int kk = 0; kk < 2; ++kk) A = MFMA32(kf[kk], qf[kk], A);
            float a[16];
#pragma unroll
            for (int e = 0; e < 16; ++e) { const int j = kt * 32 + 8 * hh + (e & 7) + 16 * (e >> 3); a[e] = (j <= i) ? A[e] : 0.f; }
            const bf16x8 p0 = pack8(a), p1 = pack8(a + 8);
            O[0] = MFMA32(vf[0][0], p0, O[0]); O[0] = MFMA32(vf[0][1], p1, O[0]);
            O[1] = MFMA32(vf[1][0], p0, O[1]); O[1] = MFMA32(vf[1][1], p1, O[1]);
        }
        float s2 = 0.f;
#pragma unroll
        for (int e = 0; e < 16; ++e) s2 += O[0][e] * O[0][e] + O[1][e] * O[1][e];
        s2 += __shfl_xor(s2, 32);
        const float rs = 1.0f / sqrtf(s2 * (1.0f / 64.0f) + NORM_EPS);
        const bf16* gp = Zr + (size_t)i * ZW + C_GR + h * 64; const float* gn = F.g_gla + l * 256 + h * 64;
        bf16* op = F.YS + (tg + i) * DM + 256 + h * 64;
#pragma unroll
        for (int dt = 0; dt < 2; ++dt)
#pragma unroll
            for (int g4 = 0; g4 < 4; ++g4) {
                const int d = dt * 32 + 8 * g4 + 4 * hh;
                const u32x2 gz = *(const u32x2*)(gp + d); const f32x4 gg = *(const f32x4*)(gn + d);
                const float z0 = __uint_as_float(gz.x << 16), z1 = __uint_as_float(gz.x & 0xffff0000u), z2 = __uint_as_float(gz.y << 16), z3 = __uint_as_float(gz.y & 0xffff0000u);
                const float y0 = O[dt][4 * g4] * rs * gg[0] * siluf_(z0), y1 = O[dt][4 * g4 + 1] * rs * gg[1] * siluf_(z1);
                const float y2 = O[dt][4 * g4 + 2] * rs * gg[2] * siluf_(z2), y3 = O[dt][4 * g4 + 3] * rs * gg[3] * siluf_(z3);
                u32x2 w; w.x = cvtpk(y0, y1); w.y = cvtpk(y2, y3); *(u32x2*)(op + d) = w;
            }
    }
}
__device__ __forceinline__ void p3b_mixers(Frame& F, int l) {
    unsigned* qctr = F.ctl + CW_Q + 64 * l;
    for (;;) {
        unsigned id = 0;
        if (F.lane == 0) id = __hip_atomic_fetch_add(qctr, 1u, __ATOMIC_RELAXED, __HIP_MEMORY_SCOPE_AGENT);
        id = (unsigned)__builtin_amdgcn_readfirstlane((int)id);
        if (id >= 6144u) break;
        if (id < 2048u) { const int qt = 63 - (int)(id >> 5), bh = id & 31; moba_task(F, bh >> 2, bh & 3, qt); }
        else if (id < 3072u) { const int q = id - 2048, n = 31 - (q >> 5), bh = q & 31; ret_task(F, l, bh >> 2, bh & 3, n); }
        else if (id < 4096u) { const int q = id - 3072, n = 31 - (q >> 5), bh = q & 31; gla_task(F, l, bh >> 2, bh & 3, n); }
        else { const int q = id - 4096, qt = q >> 5, bh = q & 31; swa_task(F, l, bh >> 2, bh & 3, qt); }
    }
}

__device__ __forceinline__ void p6_router(Frame& F, int l, const float* xin) {
    LAS float* hs = (LAS float*)(F.lds + F.wave * 16384);
    LAS int* hist = (LAS int*)(F.lds + L_HIST); LAS int* gbase = (LAS int*)(F.lds + L_GBASE);
    const float* wr = F.w_rt + (size_t)l * 1024 * 32;
    const int e = F.lane & 31, half = F.lane >> 5;
    for (int blk = F.vcu; blk < T / 64; blk += F.G) {
        if (F.tid < 32) hist[F.tid] = 0;
        __syncthreads();
        int myE = 0, myPos = 0; float myW = 0.f;
#pragma unroll 1
        for (int grp = 0; grp < 2; ++grp) {
#pragma unroll 1
            for (int tk = 0; tk < 4; ++tk) {
                const int t = blk * 64 + F.wave * 8 + grp * 4 + tk;
                f32x4 v[4]; row_load(xin + (size_t)t * DM, F.lane, v);
                const float ri = row_rinv(v); const float* mp = F.MOD + (size_t)(l * 8 + (t >> 11)) * 6144;
                row_adaln(v, ri, F.g_ffn + l * 1024, mp + 4096, mp + 3072, F.lane, F.H + (size_t)t * DM);
#pragma unroll
                for (int j = 0; j < 4; ++j) *(LAS f32x4*)(hs + tk * 1024 + 4 * F.lane + 256 * j) = v[j];
            }
            __builtin_amdgcn_wave_barrier();
            asm volatile("s_waitcnt lgkmcnt(0)" ::: "memory");
            float a[4] = {0.f, 0.f, 0.f, 0.f};
#pragma unroll 2
            for (int i4 = 0; i4 < 128; ++i4) {
                const int i = half * 512 + i4 * 4;
                const float w0 = wr[(size_t)(i + 0) * 32 + e], w1 = wr[(size_t)(i + 1) * 32 + e], w2 = wr[(size_t)(i + 2) * 32 + e], w3 = wr[(size_t)(i + 3) * 32 + e];
#pragma unroll
                for (int tk = 0; tk < 4; ++tk) { const f32x4 hv = *(const LAS f32x4*)(hs + tk * 1024 + i); a[tk] += (hv[0] * w0 + hv[1] * w1) + (hv[2] * w2 + hv[3] * w3); }
            }
            __builtin_amdgcn_wave_barrier();
            const float br = F.b_rt[l * 32 + e];
#pragma unroll
            for (int tk = 0; tk < 4; ++tk) {
                float val = a[tk] + __shfl_xor(a[tk], 32) + br;
                float tv[4]; int ti[4];
#pragma unroll
                for (int k = 0; k < 4; ++k) {
                    float bv = val; int bi = e;
#pragma unroll
                    for (int o = 1; o < 32; o <<= 1) { const float ov = __shfl_xor(bv, o); const int oi = __shfl_xor(bi, o); if (ov > bv || (ov == bv && oi < bi)) { bv = ov; bi = oi; } }
                    tv[k] = bv; ti[k] = bi; if (e == bi) val = -INFINITY;
                }
                const float e1 = __expf(tv[1] - tv[0]), e2 = __expf(tv[2] - tv[0]), e3 = __expf(tv[3] - tv[0]), inv = 1.0f / (1.0f + e1 + e2 + e3);
                const float w4[4] = {inv, e1 * inv, e2 * inv, e3 * inv};
                if ((F.lane >> 2) == grp * 4 + tk) {
                    const int k = F.lane & 3;
                    myE = k == 0 ? ti[0] : k == 1 ? ti[1] : k == 2 ? ti[2] : ti[3];
                    myW = k == 0 ? w4[0] : k == 1 ? w4[1] : k == 2 ? w4[2] : w4[3];
                }
            }
        }
        if (F.lane < 32) myPos = __hip_atomic_fetch_add(hist + myE, 1, __ATOMIC_RELAXED, __HIP_MEMORY_SCOPE_WORKGROUP);
        __syncthreads();
        if (F.tid < 32) gbase[F.tid] = (int)__hip_atomic_fetch_add(F.ctl + CW_CNT + (l * 32 + F.tid) * 64, (unsigned)hist[F.tid], __ATOMIC_RELAXED, __HIP_MEMORY_SCOPE_AGENT);
        __syncthreads();
        if (F.lane < 32) {
            const int pos = gbase[myE] + myPos, t = blk * 64 + F.wave * 8 + (F.lane >> 2), k = F.lane & 3;
            F.SELE[t * 4 + k] = myE; F.SELP[t * 4 + k] = pos;
            F.LTOK[(size_t)myE * T + pos] = t; F.LW[(size_t)myE * T + pos] = myW;
        }
        __syncthreads();
    }
}
__device__ __forceinline__ void moe_tables(Frame& F, int l) {
    LAS int* cnt = (LAS int*)(F.lds + L_CNT); LAS int* tst = (LAS int*)(F.lds + L_TST);
    if (F.tid == 0) { int run = 0;
        for (int e = 0; e < NE; ++e) { const int c = (int)__hip_atomic_load(F.ctl + CW_CNT + (l * 32 + e) * 64, __ATOMIC_RELAXED, __HIP_MEMORY_SCOPE_AGENT); cnt[e] = c; tst[e] = run; run += (c + 255) >> 8; }
        tst[NE] = run; }
    __syncthreads();
}
__device__ __forceinline__ void p9_combine(Frame& F, int l, const float* x1, float* x2) {
    const LAS int* tst = (const LAS int*)(F.lds + L_TST);
    const int gw = F.vcu * NWAVES + F.wave, NGW = F.G * NWAVES;
    for (int t = gw; t < T; t += NGW) {
        f32x4 v[4]; row_load(x1 + (size_t)t * DM, F.lane, v);
        f32x4 y[4];
#pragma unroll
        for (int j = 0; j < 4; ++j) y[j] = (f32x4){0.f, 0.f, 0.f, 0.f};
#pragma unroll
        for (int k = 0; k < 4; ++k) {
            const int e = F.SELE[t * 4 + k], pos = F.SELP[t * 4 + k];
            const bf16* yr = F.YB + ((size_t)tst[e] * 256 + pos) * DM;
#pragma unroll
            for (int j = 0; j < 4; ++j) { const u32x2 w = *(const u32x2*)(yr + 4 * F.lane + 256 * j);
                y[j][0] += __uint_as_float(w.x << 16); y[j][1] += __uint_as_float(w.x & 0xffff0000u); y[j][2] += __uint_as_float(w.y << 16); y[j][3] += __uint_as_float(w.y & 0xffff0000u); }
        }
        const float* mp = F.MOD + (size_t)(l * 8 + (t >> 11)) * 6144;
#pragma unroll
        for (int j = 0; j < 4; ++j) { const f32x4 g2 = *(const f32x4*)(mp + 5120 + 4 * F.lane + 256 * j); v[j] = v[j] + g2 * y[j]; }
        const float ri = row_rinv(v);
        if (l + 1 < DEPTH) {
#pragma unroll
            for (int j = 0; j < 4; ++j) *(f32x4*)(x2 + (size_t)t * DM + 4 * F.lane + 256 * j) = v[j];
            const float* mn = F.MOD + (size_t)((l + 1) * 8 + (t >> 11)) * 6144;
            row_adaln(v, ri, F.g_mix + (l + 1) * 1024, mn + 1024, mn, F.lane, F.H + (size_t)t * DM);
        } else {
#pragma unroll
            for (int j = 0; j < 4; ++j) { const f32x4 gf = *(const f32x4*)(F.g_fin + 4 * F.lane + 256 * j); *(f32x4*)(F.out + (size_t)t * DM + 4 * F.lane + 256 * j) = v[j] * ri * gf; }
        }
    }
}

#ifndef ONLY_KIND
#define ONLY_KIND -1
#endif
#define KIND_OK(k) (ONLY_KIND < 0 || ((k) == 0 ? ONLY_KIND == 0 : (((k) - 1) % 10) + 1 == ONLY_KIND))
#define IN(k) (KIND_OK(k) && lo <= (k) && (k) < hi)
#define SEAM(k) do { if ((k) + 1 < hi) { if (MK_PER_PHASE) { if (F.tid == 0) __hip_atomic_store(F.ctl + CW_TMO, 0xBADu, __ATOMIC_RELAXED, __HIP_MEMORY_SCOPE_AGENT); } else xcd_barrier(bar); } } while (0)

template <int l>
__device__ __forceinline__ void run_layer(Frame& F, const XcdBarrier& bar, const int lo, const int hi) {
        const int pb = 1 + 10 * l;
        const float* xin = (l == 0) ? F.x : F.X2;
        if (l == 0 && IN(pb + 0)) { p1_norm(F); SEAM(pb + 0); }
        if (IN(pb + 1)) {
            pg8::GemmDesc g{F.H, 1024, 1024, 1024};
            pg8::SchedPlain S; S.o.init(T / 256, ZW / 256, F.G, (int)blockIdx.x); S.Bt = F.WIN + (size_t)l * (WIN_STRIDE / 2);
            pg8::EpiInProj E{F.Z, F.ZT};
            pg8::gemm_phase(F.lds, g, S, E);
            SEAM(pb + 1);
        }
        if (IN(pb + 2)) { p3a_states(F, l); SEAM(pb + 2); }
        if (IN(pb + 3)) { p3b_mixers(F, l); SEAM(pb + 3); }
        if (IN(pb + 4)) {
            pg8::GemmDesc g{F.YS, 1024, 256, 256};
            pg8::SchedSeg S; S.o.init(T / 256, 4, F.G, (int)blockIdx.x); S.Bt = F.WBR + (size_t)l * 4 * 1024 * 256;
            pg8::EpiUp E{F.Z, F.PART, F.MIX};
            pg8::gemm_phase(F.lds, g, S, E);
            SEAM(pb + 4);
        }
        if (IN(pb + 5)) {
            pg8::GemmDesc g{F.MIX, 1024, 1024, 1024};
            pg8::SchedPlain S; S.o.init(T / 256, 4, F.G, (int)blockIdx.x); S.Bt = F.WOUT + (size_t)l * 1024 * 1024;
            pg8::EpiOut E{xin, F.X1, F.MOD + (size_t)l * 8 * 6144 + 2048};
            pg8::gemm_phase(F.lds, g, S, E);
            SEAM(pb + 5);
        }
        if (IN(pb + 6)) { p6_router(F, l, F.X1); SEAM(pb + 6); }
        if (IN(pb + 7)) {
            moe_tables(F, l);
            const LAS int* cnt = (const LAS int*)(F.lds + L_CNT); const LAS int* tst = (const LAS int*)(F.lds + L_TST);
            pg8::GemmDesc g{F.H, 1024, 1024, 1024};
            pg8::SchedMoe<true> S; S.o.init(tst[NE], 8, F.G, (int)blockIdx.x); S.Bt = F.WGU + (size_t)l * 32 * 2048 * 1024; S.estride = (size_t)2048 * 1024; S.tstart = tst; S.cnt = cnt; S.ltok = F.LTOK;
            pg8::EpiMoe1 E{F.ACT, F.b_gu + (size_t)l * 32 * 2048};
            pg8::gemm_phase(F.lds, g, S, E);
            SEAM(pb + 7);
        }
        if (IN(pb + 8)) {
            moe_tables(F, l);
            const LAS int* cnt = (const LAS int*)(F.lds + L_CNT); const LAS int* tst = (const LAS int*)(F.lds + L_TST);
            pg8::GemmDesc g{F.ACT, 1024, 1024, 1024};
            pg8::SchedMoe<false> S; S.o.init(tst[NE], 4, F.G, (int)blockIdx.x); S.Bt = F.WDN + (size_t)l * 32 * 1024 * 1024; S.estride = (size_t)1024 * 1024; S.tstart = tst; S.cnt = cnt; S.ltok = nullptr;
            pg8::EpiMoe2 E{F.YB, F.b_dn + (size_t)l * 32 * 1024, F.LW};
            pg8::gemm_phase(F.lds, g, S, E);
            SEAM(pb + 8);
        }
        if (IN(pb + 9)) { moe_tables(F, l); p9_combine(F, l, F.X1, F.X2); SEAM(pb + 9); }
}
constexpr int NPH = 21;
struct Args { const float* in[21]; float* out; unsigned char* ws; int ph_lo, ph_hi; };
__global__ void __launch_bounds__(NWAVES * 64, 2) mk_fwd(Args args) {
    extern __shared__ __attribute__((aligned(16))) unsigned char lds_raw[];
    Frame F;
    F.lds = (LAS unsigned char*)lds_raw;
    F.tid = threadIdx.x; F.lane = F.tid & 63; F.wave = __builtin_amdgcn_readfirstlane(F.tid >> 6);
    F.G = gridDim.x; { const int bx = blockIdx.x; F.vcu = (F.G % 8 == 0) ? (bx % 8) * (F.G / 8) + bx / 8 : bx; }
    unsigned char* ws = args.ws;
    F.ctl = (unsigned*)(ws + WS_CTL);
    F.x = args.in[0]; F.c = args.in[1]; F.w_ada = args.in[2]; F.b_ada = args.in[3]; F.g_mix = args.in[4]; F.w_in = args.in[5]; F.w_gg = args.in[6]; F.b_gg = args.in[7];
    F.g_gla = args.in[8]; F.g_ret = args.in[9]; F.sinks = args.in[10]; F.w_br = args.in[11]; F.w_out = args.in[12]; F.g_ffn = args.in[13]; F.w_rt = args.in[14]; F.b_rt = args.in[15];
    F.w_gu = args.in[16]; F.b_gu = args.in[17]; F.w_dn = args.in[18]; F.b_dn = args.in[19]; F.g_fin = args.in[20]; F.out = args.out;
    F.MOD = (float*)(ws + WS_MOD); F.KMEAN = (float*)(ws + WS_KMEAN); F.LW = (float*)(ws + WS_LW); F.KVG = (float*)(ws + WS_KVG); F.DECG = (float*)(ws + WS_DECG);
    F.KVR = (float*)(ws + WS_KVR); F.BCUM = (float*)(ws + WS_BCUM); F.PART = (float*)(ws + WS_PART); F.X1 = (float*)(ws + WS_X1); F.X2 = (float*)(ws + WS_X2);
    F.SELE = (int*)(ws + WS_SELE); F.SELP = (int*)(ws + WS_SELP); F.LTOK = (int*)(ws + WS_LTOK);
    F.WIN = (bf16*)(ws + WS_WIN); F.WBR = (bf16*)(ws + WS_WBR); F.WOUT = (bf16*)(ws + WS_WOUT); F.WGU = (bf16*)(ws + WS_WGU); F.WDN = (bf16*)(ws + WS_WDN);
    F.H = (bf16*)(ws + WS_H); F.Z = (bf16*)(ws + WS_Z); F.ZT = (bf16*)(ws + WS_ZT); F.YS = (bf16*)(ws + WS_YS); F.MIX = (bf16*)(ws + WS_MIX); F.ACT = (bf16*)(ws + WS_ACT); F.YB = (bf16*)(ws + WS_YB);
    for (int u = F.tid; u < (LDS_BYTES - LDSCTL_OFF) / 4; u += NWAVES * 64) ((LAS unsigned*)(F.lds + LDSCTL_OFF))[u] = 0u;
    __syncthreads();
    XcdBarrier bar; bar.bar = F.ctl + CW_BAR; bar.x = 0; bar.st = nullptr;
    if (!MK_PER_PHASE) bar = xcd_barrier_post(F.ctl + CW_BAR, (volatile LAS unsigned*)(F.lds + L_MISC));
    const int lo = args.ph_lo, hi = args.ph_hi;
    if (IN(0)) { p0_prologue(F); SEAM(0); }
    run_layer<0>(F, bar, lo, hi);
    run_layer<1>(F, bar, lo, hi);
#undef IN
#undef SEAM
}

extern "C" void kernel_launch(void* const* d_in, const int* in_sizes, int n_in, void* d_out, int out_size, void* d_ws, size_t ws_size, hipStream_t stream) {
    static int grid = 0;
    if (grid == 0) {
        if (n_in != 21 || out_size != T * DM || ws_size < WS_END) { fprintf(stderr, "kernel_launch: unexpected sizes (n_in %d, out %d, ws %zu < %zu); nothing launched\n", n_in, out_size, ws_size, (size_t)WS_END); grid = -1; return; }
        int dev = 0, cus = 0;
        if (hipGetDevice(&dev) != hipSuccess || hipDeviceGetAttribute(&cus, hipDeviceAttributeMultiprocessorCount, dev) != hipSuccess) { grid = -1; return; }
        if (hipFuncSetAttribute((const void*)mk_fwd, hipFuncAttributeMaxDynamicSharedMemorySize, LDS_BYTES) != hipSuccess) { fprintf(stderr, "kernel_launch: hipFuncSetAttribute failed\n"); grid = -1; return; }
        int per_cu = 0;
        if (hipOccupancyMaxActiveBlocksPerMultiprocessor(&per_cu, (const void*)mk_fwd, NWAVES * 64, LDS_BYTES) != hipSuccess || per_cu < 1) fprintf(stderr, "kernel_launch: occupancy query says %d\n", per_cu);
        (void)hipGetLastError();
        grid = cus;
    }
    if (grid < 0) return;
    (void)hipMemsetAsync((char*)d_ws + WS_CTL, 0, CTL_ZERO_BYTES, stream);
    Args a{};
    for (int i = 0; i < 21; ++i) a.in[i] = (const float*)d_in[i];
    a.out = (float*)d_out; a.ws = (unsigned char*)d_ws;
#if MK_PER_PHASE
    for (int p = 0; p < NPH; ++p) { if (p == 11) continue; a.ph_lo = p; a.ph_hi = p + 1; hipLaunchKernelGGL(mk_fwd, dim3(grid), dim3(NWAVES * 64), LDS_BYTES, stream, a); }
#else
    a.ph_lo = 0; a.ph_hi = NPH;
    hipLaunchKernelGGL(mk_fwd, dim3(grid), dim3(NWAVES * 64), LDS_BYTES, stream, a);
#endif
}
```
